# Optimizing an MI355X kernel written in HIP

```python
import jax, jax.numpy as jnp
from jax import lax
import numpy as np

D_MODEL = 1024
BATCH = 16
SEQ = 2048
DEPTH = 1

D_PLE = 256
RWKV_WIDTH = D_MODEL // 2
HEAD_SIZE = 64
N_HEADS = RWKV_WIDTH // HEAD_SIZE
POOL_WIDTH = D_MODEL - RWKV_WIDTH
POOL_WINDOWS = (2, 4, 8, 16)
N_POOL_GROUPS = len(POOL_WINDOWS)
POOL_GROUP = POOL_WIDTH // N_POOL_GROUPS
DECAY_LORA = 64
AAA_LORA = 64
GATE_LORA = 128
RWKV_SPLITS = (RWKV_WIDTH, 2 * RWKV_WIDTH, 3 * RWKV_WIDTH, 3 * RWKV_WIDTH + DECAY_LORA, 3 * RWKV_WIDTH + DECAY_LORA + AAA_LORA)
RWKV_IN = 3 * RWKV_WIDTH + DECAY_LORA + AAA_LORA + GATE_LORA
IN_WIDTH = RWKV_IN + POOL_WIDTH
D_FF = -(-8 * D_MODEL // (3 * 256)) * 256
ALPHA = (2.0 * DEPTH) ** 0.25
BETA = (8.0 * DEPTH) ** -0.25
LN_EPS = 1e-5
GN_EPS = 1e-5 * HEAD_SIZE

kernel_name = 'hybrid_rwkv7_pool_deepnorm'


def layer_norm(x, g, b, eps=LN_EPS):
    xf = x.astype(jnp.float32)
    mu = jnp.mean(xf, axis=-1, keepdims=True)
    var = jnp.mean(jnp.square(xf - mu), axis=-1, keepdims=True)
    return ((xf - mu) * lax.rsqrt(var + eps) * g + b).astype(x.dtype)


def token_shift(z):
    return jnp.pad(z, ((0, 0), (1, 0), (0, 0)))[:, :-1]


def wkv7(r, w, k, v, a, b):
    B_, T_, H_, N_ = r.shape

    def step(S, inp):
        r_t, w_t, k_t, v_t, a_t, b_t = inp
        Sa = jnp.einsum('bhvk,bhk->bhv', S, a_t)
        S = S * w_t[:, :, None, :] + Sa[..., None] * b_t[:, :, None, :] + v_t[..., None] * k_t[:, :, None, :]
        y = jnp.einsum('bhvk,bhk->bhv', S, r_t)
        return S, y

    xs = tuple(jnp.moveaxis(t, 1, 0) for t in (r, w, k, v, a, b))
    S0 = jnp.zeros((B_, H_, N_, N_), jnp.float32)
    _, ys = lax.scan(step, S0, xs)
    return jnp.moveaxis(ys, 0, 1)


def rwkv7_time_mix(z, mu, w0, wl_up, a0, al_up, gl_up, k_k, k_a, r_k, lnx_g, lnx_b):
    B_, T_, _ = z.shape
    f32 = jnp.float32
    zs = z + (token_shift(z) - z) * mu
    r, k, v, wd, ad, gd = jnp.split(zs, RWKV_SPLITS, axis=-1)
    w_log = -jax.nn.softplus(-(w0 + jnp.tanh(wd) @ wl_up)) - 0.5
    decay = jnp.exp(-jnp.exp(w_log.astype(f32)))
    a = jax.nn.sigmoid(a0 + ad @ al_up)
    g = jax.nn.sigmoid(gd) @ gl_up

    def heads(t):
        return t.astype(f32).reshape(B_, T_, N_HEADS, HEAD_SIZE)

    kk = heads(k * k_k)
    kk = kk / jnp.maximum(jnp.sqrt(jnp.sum(kk * kk, axis=-1, keepdims=True)), 1e-12)
    k2 = k * (1.0 + (a - 1.0) * k_a)
    rh, kh, vh, ah = heads(r), heads(k2), heads(v), heads(a)
    y = wkv7(rh, heads(decay), kh, vh, -kk, kk * ah)
    m = jnp.mean(y, axis=-1, keepdims=True)
    var = jnp.mean(jnp.square(y - m), axis=-1, keepdims=True)
    y = (y - m) * lax.rsqrt(var + GN_EPS) * lnx_g.reshape(N_HEADS, HEAD_SIZE) + lnx_b.reshape(N_HEADS, HEAD_SIZE)
    y = y + jnp.sum(rh * kh * r_k, axis=-1, keepdims=True) * vh
    y = y.reshape(B_, T_, RWKV_WIDTH) * g.astype(f32)
    return y.astype(z.dtype)


def multiscale_pool(u, pool_w, pool_scale):
    B_, T_, _ = u.shape
    f32 = jnp.float32
    uf = u.astype(f32).reshape(B_, T_, N_POOL_GROUPS, POOL_GROUP)
    c = jnp.cumsum(uf, axis=1)
    pos = jnp.arange(1, T_ + 1, dtype=f32)
    outs = []
    for j, W in enumerate(POOL_WINDOWS):
        cj = c[:, :, j]
        c_prev = jnp.pad(cj, ((0, 0), (W, 0), (0, 0)))[:, :T_]
        cnt = jnp.minimum(pos, float(W))
        outs.append((cj - c_prev) / cnt[None, :, None] - uf[:, :, j])
    d = jnp.stack(outs, axis=2)
    y = jnp.einsum('btgc,gcd->btgd', d, pool_w.astype(f32)).reshape(B_, T_, POOL_WIDTH)
    return (y * pool_scale.astype(f32)).astype(u.dtype)


def setup_inputs(seed: int = 0) -> dict:
    key = jax.random.key(seed)
    ks = jax.random.split(key, 32)
    f32 = jnp.float32
    L, D = DEPTH, D_MODEL

    def nrm(k, shape, scale):
        return jax.random.normal(k, shape, f32) * scale

    lin = jnp.linspace(0.0, 1.0, RWKV_WIDTH, dtype=f32)
    return {
        'x': nrm(ks[0], (BATCH, SEQ, D), 1.0),
        'p': nrm(ks[1], (L, BATCH, SEQ, D_PLE), 1.0),
        'ln_in_g': 1.0 + nrm(ks[2], (D,), 0.02),
        'ln_in_b': nrm(ks[3], (D,), 0.02),
        'w_in': nrm(ks[4], (L, D, IN_WIDTH), D ** -0.5),
        'mu_shift': jax.random.uniform(ks[5], (L, RWKV_IN), f32),
        'w0': (-6.0 + 5.0 * lin ** 0.85)[None, :] + nrm(ks[6], (L, RWKV_WIDTH), 0.1),
        'wl_up': nrm(ks[7], (L, DECAY_LORA, RWKV_WIDTH), 0.1 * DECAY_LORA ** -0.5),
        'a0': nrm(ks[8], (L, RWKV_WIDTH), 0.1),
        'al_up': nrm(ks[9], (L, AAA_LORA, RWKV_WIDTH), 0.1 * AAA_LORA ** -0.5),
        'gl_up': nrm(ks[10], (L, GATE_LORA, RWKV_WIDTH), GATE_LORA ** -0.5),
        'k_k': 0.85 + nrm(ks[11], (L, RWKV_WIDTH), 0.05),
        'k_a': 1.0 + nrm(ks[12], (L, RWKV_WIDTH), 0.05),
        'r_k': nrm(ks[13], (L, N_HEADS, HEAD_SIZE), 0.1),
        'lnx_g': 1.0 + nrm(ks[14], (L, RWKV_WIDTH), 0.02),
        'lnx_b': nrm(ks[15], (L, RWKV_WIDTH), 0.02),
        'pool_w': nrm(ks[16], (L, N_POOL_GROUPS, POOL_GROUP, POOL_GROUP), POOL_GROUP ** -0.5),
        'pool_scale': 1.0 + nrm(ks[17], (L, POOL_WIDTH), 0.1),
        'w_out': nrm(ks[18], (L, D, D), BETA * D ** -0.5),
        'ln1_g': 1.0 + nrm(ks[19], (L, D), 0.02),
        'ln1_b': nrm(ks[20], (L, D), 0.02),
        'ffn_gate': nrm(ks[21], (L, D, D_FF), D ** -0.5),
        'ffn_up': nrm(ks[22], (L, D, D_FF), D ** -0.5),
        'ffn_down': nrm(ks[23], (L, D_FF, D), BETA * D_FF ** -0.5),
        'pl_proj': nrm(ks[24], (L, D_PLE, D), BETA * D_PLE ** -0.5),
        'pl_gate': nrm(ks[25], (L, D, D), D ** -0.5),
        'ln2_g': 1.0 + nrm(ks[26], (L, D), 0.02),
        'ln2_b': nrm(ks[27], (L, D), 0.02),
    }


def reference(x, p, ln_in_g, ln_in_b, w_in, mu_shift, w0, wl_up, a0, al_up, gl_up, k_k, k_a, r_k,
              lnx_g, lnx_b, pool_w, pool_scale, w_out, ln1_g, ln1_b, ffn_gate, ffn_up, ffn_down,
              pl_proj, pl_gate, ln2_g, ln2_b):
    h = layer_norm(x, ln_in_g, ln_in_b)
    for i in range(DEPTH):
        z = h @ w_in[i]
        z_rwkv, u = z[..., :RWKV_IN], z[..., RWKV_IN:]
        y_a = rwkv7_time_mix(z_rwkv, mu_shift[i], w0[i], wl_up[i], a0[i], al_up[i], gl_up[i],
                             k_k[i], k_a[i], r_k[i], lnx_g[i], lnx_b[i])
        y_b = multiscale_pool(u, pool_w[i], pool_scale[i])
        mix = jnp.concatenate([y_a, y_b], axis=-1) @ w_out[i]
        h = layer_norm(ALPHA * h + mix, ln1_g[i], ln1_b[i])
        f = (jax.nn.silu(h @ ffn_gate[i]) * (h @ ffn_up[i])) @ ffn_down[i]
        e = jax.nn.sigmoid(h @ pl_gate[i]) * (p[i] @ pl_proj[i])
        h = layer_norm(ALPHA * h + f + e, ln2_g[i], ln2_b[i])
    return h
```

```cpp
#include <hip/hip_runtime.h>
#include <hip/hip_cooperative_groups.h>
#include <cstdio>
namespace cg = cooperative_groups;

#ifndef N_LAUNCH_MODE
#define N_LAUNCH_MODE 0
#endif

#define LAS __attribute__((address_space(3)))
typedef _Float16 half_t;
typedef _Float16 h8 __attribute__((ext_vector_type(8)));
typedef _Float16 h4 __attribute__((ext_vector_type(4)));
typedef _Float16 h2 __attribute__((ext_vector_type(2)));
typedef float f32x4 __attribute__((ext_vector_type(4)));
typedef float f32x2 __attribute__((ext_vector_type(2)));
typedef unsigned u32x4 __attribute__((ext_vector_type(4)));
typedef unsigned u32x2 __attribute__((ext_vector_type(2)));
typedef unsigned long long u64x2 __attribute__((ext_vector_type(2)));

constexpr int MTOK = 32768, SEQ = 2048, DM = 1024, NIN = 2304, RWW = 512, DFF = 2816, DPLE = 256, NH = 8;
constexpr float ALPHA = 1.189207115f;
constexpr float LN_EPS = 1e-5f, GN_EPS = 64e-5f;
constexpr int NTHREADS = 512;
constexpr int LDS_BYTES = 131072;
constexpr int NPHASE = 11;

constexpr size_t MiB = 1024 * 1024;
constexpr size_t WS_WIN = 1 * MiB;
constexpr size_t WS_WOUT = WS_WIN + (size_t)NIN * DM * 2;
constexpr size_t WS_WGU = WS_WOUT + (size_t)DM * DM * 2;
constexpr size_t WS_WDN = WS_WGU + (size_t)2 * DFF * DM * 2;
constexpr size_t WS_WPLG = WS_WDN + (size_t)DM * DFF * 2;
constexpr size_t WS_WPLP = WS_WPLG + (size_t)DM * DM * 2;
constexpr size_t WS_WLORA = WS_WPLP + (size_t)DM * DPLE * 2;
constexpr size_t WS_WPOOL = WS_WLORA + (size_t)1536 * 256 * 2;
constexpr size_t WS_WEND = WS_WPOOL + (size_t)512 * 512 * 2;
static_assert(WS_WEND <= 30 * MiB, "weights region");
constexpr size_t WS_BON = 30 * MiB;
constexpr size_t WS_H0 = 32 * MiB;
constexpr size_t WS_Z = 96 * MiB;
constexpr size_t WS_LO = 240 * MiB;
constexpr size_t WS_AL = 336 * MiB;
constexpr size_t WS_DP = 352 * MiB;
constexpr size_t WS_P16 = 384 * MiB;
constexpr size_t WS_Y = 400 * MiB;
constexpr size_t WS_END = 464 * MiB;
constexpr size_t WS_H1 = WS_Z;
constexpr size_t WS_ACT = WS_Z + 64 * MiB;
constexpr size_t WS_E2 = WS_Y;
static_assert(WS_ACT + (size_t)MTOK * DFF * 2 <= WS_AL, "ACT alias");

struct Params {
    const float* in[28];
    float* out;
    unsigned char* ws;
    int ph_lo, ph_hi;
};

__device__ __forceinline__ unsigned pk2h(float a, float b) { h2 v; v.x = (_Float16)a; v.y = (_Float16)b; return __builtin_bit_cast(unsigned, v); }
__device__ __forceinline__ float sigm(float x) { return __builtin_amdgcn_rcpf(1.0f + __builtin_amdgcn_exp2f(-1.44269504f * x)); }
template <int CTRL> __device__ __forceinline__ float dpp_get(float v) { return __int_as_float(__builtin_amdgcn_update_dpp(0, __float_as_int(v), CTRL, 0xF, 0xF, false)); }
__device__ __forceinline__ float red8(float v) { v += dpp_get<0xB1>(v); v += dpp_get<0x4E>(v); v += dpp_get<0x141>(v); return v; }
__device__ __forceinline__ float red16(float v) { v = red8(v); v += dpp_get<0x140>(v); return v; }
__device__ __forceinline__ float wave_sum(float v) { v = red16(v); v += __shfl_xor(v, 16); v += __shfl_xor(v, 32); return v; }

namespace pg8 {
constexpr int BM = 256, BK = 64, HALF = 128, HTB = HALF * BK * 2, STAGE_BYTES = 8 * HTB, NXCD = 8, WGM = 8;
__device__ __forceinline__ int lds_byte(int r, int c) { const int st = (r >> 4) * 2 + (c >> 5), rr = r & 15, cc = c & 31, ob = rr * 64 + cc * 2; return st * 1024 + (ob ^ (((ob >> 9) & 1) << 5)); }
__device__ __forceinline__ void stage_rc(int b, int& R, int& C) { const int st = b / 1024, sb = b % 1024, swz = sb ^ (((sb >> 9) & 1) << 5); R = (st >> 1) * 16 + swz / 64; C = (st & 1) * 32 + (swz % 64) / 2; }
__device__ __forceinline__ int perm32(int rho) { const int n = rho >> 4, i = rho & 15; return 8 * (i >> 2) + 4 * n + (i & 3); }

struct Unit { int pm, pn; };
struct Gemm { const half_t* A; const half_t* Bt; int M, N, K; };
struct StaticOrder {
    int nM, nN, nwg, G, c;
    __device__ void init(int M, int N, int G_, int c_) { nM = M / BM; nN = N / BM; nwg = nM * nN; G = G_; c = c_; }
    __device__ bool next(int i, Unit& u) const {
        const long L = (long)i * G + c; if (L >= nwg) return false;
        int wgid = (int)L; { const int q = nwg / NXCD, r = nwg % NXCD, xcd = wgid % NXCD, off = wgid / NXCD; wgid = (xcd < r ? xcd * (q + 1) : r * (q + 1) + (xcd - r) * q) + off; }
        const int nig = WGM * nN, gid = wgid / nig, fm = gid * WGM, gsz = (nM - fm) < WGM ? (nM - fm) : WGM;
        u.pm = fm + ((wgid % nig) % gsz); u.pn = (wgid % nig) / gsz; return true;
    }
};


struct EpiH {
    static constexpr bool PERM = true;
    half_t* O; int ldc; int coff; const float* scale;
    __device__ __forceinline__ void operator()(const f32x4 (&acc)[2][2][4][2], const Unit& u, int wr, int wc, int fr, int fq) const {
        const int row0 = u.pm * BM + wr * 64 + fr, col0 = u.pn * BM + wc * 32 + 8 * fq;
        f32x4 sv[2][2];
#pragma unroll
        for (int bj = 0; bj < 2; ++bj)
#pragma unroll
            for (int n = 0; n < 2; ++n) sv[bj][n] = scale ? *(const f32x4*)(scale + col0 + bj * HALF + 4 * n) : (f32x4){1.f, 1.f, 1.f, 1.f};
#pragma unroll
        for (int ai = 0; ai < 2; ++ai)
#pragma unroll
            for (int m = 0; m < 4; ++m) { half_t* rowp = O + (size_t)(row0 + ai * HALF + m * 16) * ldc + coff + col0;
#pragma unroll
                for (int bj = 0; bj < 2; ++bj) { const f32x4 v0 = acc[ai][bj][m][0] * sv[bj][0], v1 = acc[ai][bj][m][1] * sv[bj][1];
                    u32x4 w; w.x = pk2h(v0[0], v0[1]); w.y = pk2h(v0[2], v0[3]); w.z = pk2h(v1[0], v1[1]); w.w = pk2h(v1[2], v1[3]);
                    *(u32x4*)(rowp + bj * HALF) = w; } }
    }
};
struct EpiSwiGLU {
    static constexpr bool PERM = true;
    half_t* O; int ldc;
    __device__ __forceinline__ void operator()(const f32x4 (&acc)[2][2][4][2], const Unit& u, int wr, int wc, int fr, int fq) const {
        const int row0 = u.pm * BM + wr * 64 + fr, col0 = u.pn * HALF + wc * 32 + 8 * fq;
#pragma unroll
        for (int ai = 0; ai < 2; ++ai)
#pragma unroll
            for (int m = 0; m < 4; ++m) { half_t* rowp = O + (size_t)(row0 + ai * HALF + m * 16) * ldc + col0;
                float r[8];
#pragma unroll
                for (int n = 0; n < 2; ++n)
#pragma unroll
                    for (int j = 0; j < 4; ++j) { const float g = acc[ai][0][m][n][j], up = acc[ai][1][m][n][j]; r[n * 4 + j] = g * sigm(g) * up; }
                u32x4 w; w.x = pk2h(r[0], r[1]); w.y = pk2h(r[2], r[3]); w.z = pk2h(r[4], r[5]); w.w = pk2h(r[6], r[7]);
                *(u32x4*)rowp = w; }
    }
};
struct EpiE {
    static constexpr bool PERM = true;
    half_t* E; int ldc;
    __device__ __forceinline__ void operator()(const f32x4 (&acc)[2][2][4][2], const Unit& u, int wr, int wc, int fr, int fq) const {
        const int row0 = u.pm * BM + wr * 64 + fr, col0 = u.pn * BM + wc * 32 + 8 * fq;
#pragma unroll
        for (int ai = 0; ai < 2; ++ai)
#pragma unroll
            for (int m = 0; m < 4; ++m) { half_t* rowp = E + (size_t)(row0 + ai * HALF + m * 16) * ldc + col0;
#pragma unroll
                for (int bj = 0; bj < 2; ++bj) {
                    const unsigned long long* ep = (const unsigned long long*)(rowp + bj * HALF);
                    u64x2 e01; e01.x = __hip_atomic_load(ep, __ATOMIC_RELAXED, __HIP_MEMORY_SCOPE_AGENT); e01.y = __hip_atomic_load(ep + 1, __ATOMIC_RELAXED, __HIP_MEMORY_SCOPE_AGENT);
                    const h8 e = __builtin_bit_cast(h8, e01); float r[8];
#pragma unroll
                    for (int n = 0; n < 2; ++n)
#pragma unroll
                        for (int j = 0; j < 4; ++j) r[n * 4 + j] = sigm(acc[ai][bj][m][n][j]) * (float)e[n * 4 + j];
                    u32x4 w; w.x = pk2h(r[0], r[1]); w.y = pk2h(r[2], r[3]); w.z = pk2h(r[4], r[5]); w.w = pk2h(r[6], r[7]);
                    *(u32x4*)(rowp + bj * HALF) = w; } }
    }
};
template <bool HAS2> struct EpiRes {
    static constexpr bool PERM = false;
    float* C; const half_t* R1; const half_t* R2; int ldc;
    __device__ __forceinline__ void operator()(const f32x4 (&acc)[2][2][4][2], const Unit& u, int wr, int wc, int fr, int fq) const {
        const int row0 = u.pm * BM + wr * 64 + fr, col0 = u.pn * BM + wc * 32 + 4 * fq;
#pragma unroll
        for (int ai = 0; ai < 2; ++ai)
#pragma unroll
            for (int m = 0; m < 4; ++m) { const size_t off = (size_t)(row0 + ai * HALF + m * 16) * ldc + col0;
#pragma unroll
                for (int bj = 0; bj < 2; ++bj)
#pragma unroll
                    for (int n = 0; n < 2; ++n) { const size_t o = off + bj * HALF + n * 16; const h4 a = *(const h4*)(R1 + o);
                        f32x4 v = acc[ai][bj][m][n]; v[0] += ALPHA * (float)a[0]; v[1] += ALPHA * (float)a[1]; v[2] += ALPHA * (float)a[2]; v[3] += ALPHA * (float)a[3];
                        if (HAS2) { const h4 e = *(const h4*)(R2 + o); v[0] += (float)e[0]; v[1] += (float)e[1]; v[2] += (float)e[2]; v[3] += (float)e[3]; }
                        *(f32x4*)(C + o) = v; } }
    }
};

template <class Epi>
__device__ __forceinline__ void gemm_phase(LAS unsigned char* lds, const Gemm g, const StaticOrder& S, const Epi& E) {
    const int tid = threadIdx.x, wid = __builtin_amdgcn_readfirstlane(tid >> 6), lane = tid & 63, wr = wid >> 2, wc = wid & 3, fr = lane & 15, fq = lane >> 4;
    const int K = g.K, nt = K / BK;
    unsigned voffA[2], voffB[2];
#pragma unroll
    for (int i = 0; i < 2; ++i) { int R, C; stage_rc(tid * 16 + i * 8192, R, C); const int Rb = Epi::PERM ? ((R & ~31) + perm32(R & 31)) : R;
        voffA[i] = (unsigned)(R * K + C) * 2u; voffB[i] = (unsigned)(Rb * K + C) * 2u; }
    const size_t kstep = (size_t)(BK * 2);
    const size_t hstep = (size_t)HALF * K * 2;
    const size_t tstep = 2 * hstep;
    const unsigned ldsw = (unsigned)wid * 1024u;
    const int aoff = lds_byte(wr * 64 + fr, fq * 8), boff = lds_byte(wc * 32 + fr, fq * 8);
#define PG8_SA(b, h) (((b) * 2 + (h)) * HTB)
#define PG8_SB(b, h) ((4 + (b) * 2 + (h)) * HTB)
#define PG8_STAGE(bufoff, gbase, voff) do { _Pragma("unroll") for (int _i = 0; _i < 2; ++_i) \
        __builtin_amdgcn_global_load_lds((const unsigned*)((const char*)(gbase) + (voff)[_i]), (LAS unsigned*)(lds + (bufoff) + ldsw + _i * 8192), 16, 0, 0); } while (0)
#define PG8_LDA(dst, b, h) do { _Pragma("unroll") for (int m = 0; m < 4; ++m) _Pragma("unroll") for (int k = 0; k < 2; ++k) dst[m][k] = *(const LAS h8*)(lds + PG8_SA(b, h) + aoff + m * 2048 + k * 1024); } while (0)
#define PG8_LDB(dst, b, h) do { _Pragma("unroll") for (int n = 0; n < 2; ++n) _Pragma("unroll") for (int k = 0; k < 2; ++k) dst[n][k] = *(const LAS h8*)(lds + PG8_SB(b, h) + boff + n * 2048 + k * 1024); } while (0)
#define PG8_MMA(ai, bj, At, Bt) do { __builtin_amdgcn_s_setprio(1); _Pragma("unroll") for (int m = 0; m < 4; ++m) _Pragma("unroll") for (int n = 0; n < 2; ++n) _Pragma("unroll") for (int k = 0; k < 2; ++k) \
        acc[ai][bj][m][n] = __builtin_amdgcn_mfma_f32_16x16x32_f16(Bt[n][k], At[m][k], acc[ai][bj][m][n], 0, 0, 0); __builtin_amdgcn_s_setprio(0); } while (0)
#define PG8_WAIT_V(n) asm volatile("s_waitcnt vmcnt(" #n ")" ::: "memory")
#define PG8_WAIT_L(n) asm volatile("s_waitcnt lgkmcnt(" #n ")" ::: "memory")
#define PG8_BAR __builtin_amdgcn_s_barrier()
#define PG8_SCHED __builtin_amdgcn_sched_barrier(0)
    Unit cur, nxt; int ui = 0;
    if (!S.next(0, cur)) return;
    f32x4 acc[2][2][4][2];
#pragma unroll
    for (int a = 0; a < 2; ++a)
#pragma unroll
        for (int b = 0; b < 2; ++b)
#pragma unroll
            for (int m = 0; m < 4; ++m)
#pragma unroll
                for (int n = 0; n < 2; ++n) acc[a][b][m][n] = (f32x4){0.f, 0.f, 0.f, 0.f};
    h8 At[4][2], B0[2][2], B1[2][2];
    const char* cA = (const char*)g.A + (size_t)cur.pm * tstep; const char* cB = (const char*)g.Bt + (size_t)cur.pn * tstep;
    PG8_STAGE(PG8_SB(0, 0), cB, voffB); PG8_STAGE(PG8_SA(0, 0), cA, voffA); PG8_STAGE(PG8_SB(0, 1), cB + hstep, voffB); PG8_STAGE(PG8_SA(0, 1), cA + hstep, voffA);
    if (wr == 1) PG8_BAR;
    PG8_WAIT_V(4); PG8_BAR;
    PG8_STAGE(PG8_SB(1, 0), cB + kstep, voffB); PG8_STAGE(PG8_SA(1, 0), cA + kstep, voffA); PG8_STAGE(PG8_SB(1, 1), cB + hstep + kstep, voffB);
    PG8_WAIT_V(6); PG8_BAR;
    for (;;) {
        const bool has_next = S.next(ui + 1, nxt);
        const char* nA = has_next ? (const char*)g.A + (size_t)nxt.pm * tstep : cA; const char* nB = has_next ? (const char*)g.Bt + (size_t)nxt.pn * tstep : cB;
        for (int t = 0; t < nt; t += 2) {
            const bool last = (t == nt - 2);
            const char* a1 = cA + (size_t)(t + 1) * kstep;
            const char* a2 = last ? nA : cA + (size_t)(t + 2) * kstep; const char* b2 = last ? nB : cB + (size_t)(t + 2) * kstep;
            const char* a3 = a2 + kstep; const char* b3 = b2 + kstep;
            PG8_LDB(B0, 0, 0); PG8_SCHED; PG8_LDA(At, 0, 0); PG8_STAGE(PG8_SA(1, 1), a1 + hstep, voffA);
            PG8_WAIT_L(8); PG8_BAR; PG8_WAIT_L(0); PG8_MMA(0, 0, At, B0); PG8_BAR; PG8_SCHED;
            PG8_LDB(B1, 0, 1); PG8_STAGE(PG8_SB(0, 0), b2, voffB);
            PG8_BAR; PG8_WAIT_L(0); PG8_MMA(0, 1, At, B1); PG8_BAR;
            PG8_LDA(At, 0, 1); PG8_STAGE(PG8_SA(0, 0), a2, voffA);
            PG8_BAR; PG8_WAIT_L(0); PG8_MMA(1, 0, At, B0); PG8_BAR; PG8_SCHED;
            PG8_STAGE(PG8_SB(0, 1), b2 + hstep, voffB);
            PG8_WAIT_V(6); PG8_BAR; PG8_MMA(1, 1, At, B1); PG8_BAR;
            PG8_LDB(B0, 1, 0); PG8_SCHED; PG8_LDA(At, 1, 0); PG8_STAGE(PG8_SA(0, 1), a2 + hstep, voffA);
            PG8_WAIT_L(8); PG8_BAR; PG8_WAIT_L(0); PG8_MMA(0, 0, At, B0); PG8_BAR; PG8_SCHED;
            PG8_LDB(B1, 1, 1); PG8_STAGE(PG8_SB(1, 0), b3, voffB);
            PG8_BAR; PG8_WAIT_L(0); PG8_MMA(0, 1, At, B1); PG8_BAR;
            PG8_LDA(At, 1, 1); PG8_STAGE(PG8_SA(1, 0), a3, voffA);
            PG8_BAR; PG8_WAIT_L(0); PG8_MMA(1, 0, At, B0); PG8_BAR; PG8_SCHED;
            PG8_STAGE(PG8_SB(1, 1), b3 + hstep, voffB);
            PG8_WAIT_V(6); PG8_BAR; PG8_MMA(1, 1, At, B1); PG8_BAR;
        }
        E(acc, cur, wr, wc, fr, fq);
        if (!has_next) break;
#pragma unroll
        for (int a = 0; a < 2; ++a)
#pragma unroll
            for (int b = 0; b < 2; ++b)
#pragma unroll
                for (int m = 0; m < 4; ++m)
#pragma unroll
                    for (int n = 0; n < 2; ++n) acc[a][b][m][n] = (f32x4){0.f, 0.f, 0.f, 0.f};
        cur = nxt; cA = nA; cB = nB; ++ui;
    }
    PG8_WAIT_V(0);
    if (wr == 0) PG8_BAR;
    PG8_BAR;
#undef PG8_SA
#undef PG8_SB
#undef PG8_STAGE
#undef PG8_LDA
#undef PG8_LDB
#undef PG8_MMA
#undef PG8_WAIT_V
#undef PG8_WAIT_L
#undef PG8_BAR
#undef PG8_SCHED
}
}

__device__ __forceinline__ void transpose_tile(LAS float* tile, const float* __restrict__ src, int N, int k0, int n0, half_t* __restrict__ dst, int ldd, int drow0) {
    const int tid = threadIdx.x;
#pragma unroll
    for (int i = 0; i < 8; ++i) { const int kk = i * 8 + (tid >> 6), nn = tid & 63; tile[kk * 65 + nn] = src[(size_t)(k0 + kk) * N + n0 + nn]; }
    __syncthreads();
    { const int n = tid >> 3, kq = tid & 7; float v[8];
#pragma unroll
        for (int j = 0; j < 8; ++j) v[j] = tile[(kq * 8 + j) * 65 + n];
        u32x4 w; w.x = pk2h(v[0], v[1]); w.y = pk2h(v[2], v[3]); w.z = pk2h(v[4], v[5]); w.w = pk2h(v[6], v[7]);
        *(u32x4*)(dst + (size_t)(drow0 + n) * ldd + k0 + kq * 8) = w; }
    __syncthreads();
}

__device__ __forceinline__ void ln_row_to_f16(const float* __restrict__ xrow, const float* __restrict__ g, const float* __restrict__ b, half_t* __restrict__ orow, int lane) {
    f32x4 v[4]; float s = 0.f;
#pragma unroll
    for (int j = 0; j < 4; ++j) { v[j] = *(const f32x4*)(xrow + j * 256 + lane * 4); s += (v[j][0] + v[j][1]) + (v[j][2] + v[j][3]); }
    const float mu = wave_sum(s) * (1.0f / 1024.0f); float q = 0.f;
#pragma unroll
    for (int j = 0; j < 4; ++j) { v[j] = v[j] - mu; q += (v[j][0] * v[j][0] + v[j][1] * v[j][1]) + (v[j][2] * v[j][2] + v[j][3] * v[j][3]); }
    const float rstd = __builtin_amdgcn_rsqf(wave_sum(q) * (1.0f / 1024.0f) + LN_EPS);
#pragma unroll
    for (int j = 0; j < 4; ++j) { const f32x4 gg = *(const f32x4*)(g + j * 256 + lane * 4), bb = *(const f32x4*)(b + j * 256 + lane * 4); const f32x4 o = v[j] * rstd * gg + bb;
        u32x2 w; w.x = pk2h(o[0], o[1]); w.y = pk2h(o[2], o[3]); *(u32x2*)(orow + j * 256 + lane * 4) = w; }
}

__device__ void phase_prologue(LAS unsigned char* lds, const Params& P) {
    unsigned char* ws = P.ws;
    const int tid = threadIdx.x, G = gridDim.x, bx = blockIdx.x;
    LAS float* tile = (LAS float*)lds;
    const int T0 = 16 * 36, T1 = T0 + 16 * 16, T2 = T1 + 16 * 44, T3 = T2 + 16 * 44, T4 = T3 + 44 * 16, T5 = T4 + 16 * 16, T6 = T5 + 4 * 16;
    for (int t = bx; t < T6; t += G) {
        const float* src; int N, loc, ldd, kind = 0; half_t* dst;
        if (t < T0) { src = P.in[4]; N = NIN; loc = t; dst = (half_t*)(ws + WS_WIN); ldd = DM; }
        else if (t < T1) { src = P.in[18]; N = DM; loc = t - T0; dst = (half_t*)(ws + WS_WOUT); ldd = DM; }
        else if (t < T2) { src = P.in[21]; N = DFF; loc = t - T1; dst = (half_t*)(ws + WS_WGU); ldd = DM; kind = 1; }
        else if (t < T3) { src = P.in[22]; N = DFF; loc = t - T2; dst = (half_t*)(ws + WS_WGU); ldd = DM; kind = 2; }
        else if (t < T4) { src = P.in[23]; N = DM; loc = t - T3; dst = (half_t*)(ws + WS_WDN); ldd = DFF; }
        else if (t < T5) { src = P.in[25]; N = DM; loc = t - T4; dst = (half_t*)(ws + WS_WPLG); ldd = DM; }
        else { src = P.in[24]; N = DM; loc = t - T5; dst = (half_t*)(ws + WS_WPLP); ldd = DPLE; }
        const int ntn = N / 64, kt = loc / ntn, nt_ = loc % ntn, n0 = nt_ * 64;
        int drow0 = n0;
        if (kind) drow0 = (n0 >> 7) * 256 + (n0 & 127) + (kind == 2 ? 128 : 0);
        transpose_tile(tile, src, N, kt * 64, n0, dst, ldd, drow0);
    }
    const int gtid = bx * NTHREADS + tid, gth = G * NTHREADS;
    { half_t* wl = (half_t*)(ws + WS_WLORA);
        for (int i = gtid; i < 1536 * 256; i += gth) { const int n = i >> 8, k = i & 255; float v = 0.f;
            if (n < 512) { if (k < 64) v = P.in[7][k * 512 + n]; }
            else if (n < 1024) { if (k >= 64 && k < 128) v = P.in[9][(k - 64) * 512 + (n - 512)]; }
            else { if (k >= 128) v = P.in[10][(k - 128) * 512 + (n - 1024)]; }
            wl[i] = (half_t)v; } }
    { half_t* wp = (half_t*)(ws + WS_WPOOL);
        for (int i = gtid; i < 512 * 512; i += gth) { const int n = i >> 9, k = i & 511; float v = 0.f;
            if ((n >> 7) == (k >> 7)) v = P.in[16][(size_t)(n >> 7) * 16384 + (k & 127) * 128 + (n & 127)];
            wp[i] = (half_t)v; } }
    { const f32x4* p4 = (const f32x4*)P.in[1]; u32x2* o = (u32x2*)(ws + WS_P16);
        for (int i = gtid; i < MTOK * DPLE / 4; i += gth) { const f32x4 v = p4[i]; u32x2 w; w.x = pk2h(v[0], v[1]); w.y = pk2h(v[2], v[3]); o[i] = w; } }
    { const int lane = tid & 63, wv = tid >> 6; half_t* h0 = (half_t*)(ws + WS_H0);
        for (int row = bx * 8 + wv; row < MTOK; row += G * 8) ln_row_to_f16(P.in[0] + (size_t)row * DM, P.in[2], P.in[3], h0 + (size_t)row * DM, lane); }
}

__device__ void phase_prep(const Params& P) {
    unsigned char* ws = P.ws;
    const half_t* Z = (const half_t*)(ws + WS_Z); half_t* AL = (half_t*)(ws + WS_AL); half_t* DP = (half_t*)(ws + WS_DP);
    const float* mu = P.in[5];
    const int gtid = blockIdx.x * NTHREADS + threadIdx.x, gth = gridDim.x * NTHREADS;
    for (int i = gtid; i < MTOK * 96; i += gth) {
        const int m = i / 96, j = i - m * 96, t = m & (SEQ - 1);
        const half_t* zrow = Z + (size_t)m * NIN;
        if (j < 32) {
            const int cz = 1536 + j * 8;
            const h8 zc = *(const h8*)(zrow + cz); h8 zp;
            if (t > 0) zp = *(const h8*)(zrow - NIN + cz); else zp = (h8){0, 0, 0, 0, 0, 0, 0, 0};
            const f32x4 m0 = *(const f32x4*)(mu + cz), m1 = *(const f32x4*)(mu + cz + 4); float r[8];
#pragma unroll
            for (int e = 0; e < 8; ++e) { const float zz = (float)zc[e], mm = e < 4 ? m0[e & 3] : m1[e & 3]; float v = zz + ((float)zp[e] - zz) * mm;
                if (j < 8) { const float tt = __builtin_amdgcn_exp2f(2.88539008f * v); v = 1.0f - 2.0f * __builtin_amdgcn_rcpf(1.0f + tt); }
                else if (j >= 16) v = sigm(v);
                r[e] = v; }
            u32x4 w; w.x = pk2h(r[0], r[1]); w.y = pk2h(r[2], r[3]); w.z = pk2h(r[4], r[5]); w.w = pk2h(r[6], r[7]);
            *(u32x4*)(AL + (size_t)m * 256 + j * 8) = w;
        } else {
            const int jc = j - 32, cu = 1792 + jc * 8, W = 2 << (jc >> 4);
            const int cnt = (t + 1) < W ? (t + 1) : W;
            const h8 uc = *(const h8*)(zrow + cu); float s[8];
#pragma unroll
            for (int e = 0; e < 8; ++e) s[e] = (float)uc[e];
            for (int q = 1; q < cnt; ++q) { const h8 uq = *(const h8*)(zrow - (size_t)q * NIN + cu);
#pragma unroll
                for (int e = 0; e < 8; ++e) s[e] += (float)uq[e]; }
            const float inv = 1.0f / (float)cnt; float r[8];
#pragma unroll
            for (int e = 0; e < 8; ++e) r[e] = s[e] * inv - (float)uc[e];
            u32x4 w; w.x = pk2h(r[0], r[1]); w.y = pk2h(r[2], r[3]); w.z = pk2h(r[4], r[5]); w.w = pk2h(r[6], r[7]);
            *(u32x4*)(DP + (size_t)m * 512 + jc * 8) = w;
        }
    }
}

constexpr int TC = 32;
constexpr int STEPF = 384;
constexpr int SC_BUF = 0, SC_SCAL = 2 * TC * STEPF * 4, SC_YB = SC_SCAL + 2 * TC * 2 * 4, SC_END = SC_YB + 2 * TC * 32 * 4;
static_assert(SC_END <= LDS_BYTES, "scan lds");

__device__ void phase_scan(LAS unsigned char* lds, const Params& P) {
    unsigned char* ws = P.ws;
    const half_t* Z = (const half_t*)(ws + WS_Z); const half_t* LO = (const half_t*)(ws + WS_LO);
    float* BON = (float*)(ws + WS_BON); float* YR = P.out;
    const int tid = threadIdx.x, lane = tid & 63, wave = __builtin_amdgcn_readfirstlane(tid >> 6);
    LAS float* bufs = (LAS float*)(lds + SC_BUF); LAS float* scal = (LAS float*)(lds + SC_SCAL); LAS float* ybs = (LAS float*)(lds + SC_YB);
    for (int item = blockIdx.x; item < 256; item += gridDim.x) {
        const int half = item & 1, bh = item >> 1, h = bh & 7, b = bh >> 3;
        if (wave >= 4) {
            const int pw = wave - 4, c = lane, hc = h * 64 + c;
            const float mu_r = P.in[5][hc], mu_k = P.in[5][512 + hc], mu_v = P.in[5][1024 + hc];
            const float w0c = P.in[6][hc], a0c = P.in[8][hc], kkc = P.in[11][hc], kac = P.in[12][hc], rkc = P.in[13][hc];
            const size_t mb = (size_t)b * SEQ;
            for (int ch = -1; ch < 64; ++ch) {
                const int pc = ch + 1;
                if (pc < 64) {
                    LAS float* dst = bufs + (pc & 1) * (TC * STEPF); LAS float* dsc = scal + (pc & 1) * (TC * 2);
                    const int t0 = pc * TC + pw * 8;
                    half_t zr[9], zk[9], zv[9], lw[8], la[8];
                    if (t0 > 0) { const half_t* zp = Z + (mb + t0 - 1) * NIN; zr[0] = zp[hc]; zk[0] = zp[512 + hc]; zv[0] = zp[1024 + hc]; }
                    else { zr[0] = (half_t)0; zk[0] = (half_t)0; zv[0] = (half_t)0; }
#pragma unroll
                    for (int i = 0; i < 8; ++i) { const half_t* zp = Z + (mb + t0 + i) * NIN; const half_t* lp = LO + (mb + t0 + i) * 1536;
                        zr[i + 1] = zp[hc]; zk[i + 1] = zp[512 + hc]; zv[i + 1] = zp[1024 + hc]; lw[i] = lp[hc]; la[i] = lp[512 + hc]; }
#pragma unroll
                    for (int i = 0; i < 8; ++i) {
                        const int tt = pw * 8 + i;
                        const float r0 = (float)zr[i + 1], k0 = (float)zk[i + 1], v0 = (float)zv[i + 1];
                        const float r = r0 + ((float)zr[i] - r0) * mu_r, k = k0 + ((float)zk[i] - k0) * mu_k, v = v0 + ((float)zv[i] - v0) * mu_v;
                        const float sg = sigm(w0c + (float)lw[i]);
                        const float w = __builtin_amdgcn_exp2f(-0.875057039f * sg);
                        const float a = sigm(a0c + (float)la[i]);
                        const float kq = k * kkc;
                        const float ss = wave_sum(kq * kq);
                        const float kk = kq / fmaxf(sqrtf(ss), 1e-12f);
                        const float k2 = k * (1.0f + (a - 1.0f) * kac);
                        const float bn = -kk * a;
                        const float pr = k2 * r;
                        const float br = wave_sum(bn * r), kr = wave_sum(pr), bon = wave_sum(pr * rkc);
                        LAS float* d = dst + tt * STEPF + c;
                        d[0] = kk; d[64] = w * r; d[128] = w; d[192] = k2; d[256] = bn; d[320] = v;
                        if (lane == 0) { dsc[tt * 2] = br; dsc[tt * 2 + 1] = kr; if (half == 0) BON[(mb + t0 + i) * 8 + h] = bon; }
                    }
                }
                if (ch >= 1) {
                    const int fc = ch - 1; const LAS float* yb = ybs + (fc & 1) * (TC * 32);
                    const int ptid = tid - 256, tt = ptid >> 3, q = ptid & 7;
                    const f32x4 v = *(const LAS f32x4*)(yb + tt * 32 + q * 4);
                    *(f32x4*)(YR + (mb + fc * TC + tt) * 512 + h * 64 + half * 32 + q * 4) = v;
                }
                __syncthreads();
            }
            { const int fc = 63; const LAS float* yb = ybs + (fc & 1) * (TC * 32);
                const int ptid = tid - 256, tt = ptid >> 3, q = ptid & 7;
                const f32x4 v = *(const LAS f32x4*)(yb + tt * 32 + q * 4);
                *(f32x4*)(YR + (mb + fc * TC + tt) * 512 + h * 64 + half * 32 + q * 4) = v; }
            __syncthreads();
        } else {
            const int row = wave * 8 + (lane >> 3), kl = lane & 7;
            f32x2 S0 = {0.f, 0.f}, S1 = {0.f, 0.f}, S2 = {0.f, 0.f}, S3 = {0.f, 0.f};
            __syncthreads();
            for (int ch = 0; ch < 64; ++ch) {
                const LAS float* src = bufs + (ch & 1) * (TC * STEPF); const LAS float* ssc = scal + (ch & 1) * (TC * 2); LAS float* yb = ybs + (ch & 1) * (TC * 32);
#pragma unroll 4
                for (int tt = 0; tt < TC; ++tt) {
                    const LAS float* sb = src + tt * STEPF + kl * 8;
                    const f32x4 kkA = *(const LAS f32x4*)(sb), kkB = *(const LAS f32x4*)(sb + 4);
                    const f32x4 wrA = *(const LAS f32x4*)(sb + 64), wrB = *(const LAS f32x4*)(sb + 68);
                    const f32x4 wA = *(const LAS f32x4*)(sb + 128), wB = *(const LAS f32x4*)(sb + 132);
                    const f32x4 k2A = *(const LAS f32x4*)(sb + 192), k2B = *(const LAS f32x4*)(sb + 196);
                    const f32x4 bnA = *(const LAS f32x4*)(sb + 256), bnB = *(const LAS f32x4*)(sb + 260);
                    const float vv = src[tt * STEPF + 320 + half * 32 + row];
                    const f32x2 sc = *(const LAS f32x2*)(ssc + tt * 2);
                    f32x2 pa2 = S0 * (f32x2){kkA[0], kkA[1]}; pa2 = S1 * (f32x2){kkA[2], kkA[3]} + pa2; pa2 = S2 * (f32x2){kkB[0], kkB[1]} + pa2; pa2 = S3 * (f32x2){kkB[2], kkB[3]} + pa2;
                    f32x2 py2 = S0 * (f32x2){wrA[0], wrA[1]}; py2 = S1 * (f32x2){wrA[2], wrA[3]} + py2; py2 = S2 * (f32x2){wrB[0], wrB[1]} + py2; py2 = S3 * (f32x2){wrB[2], wrB[3]} + py2;
                    float pa = pa2[0] + pa2[1], py = py2[0] + py2[1];
                    pa = red8(pa); py = red8(py);
                    const f32x2 vv2 = {vv, vv}, pav = {pa, pa};
                    S0 = S0 * (f32x2){wA[0], wA[1]} + vv2 * (f32x2){k2A[0], k2A[1]}; S0 = pav * (f32x2){bnA[0], bnA[1]} + S0;
                    S1 = S1 * (f32x2){wA[2], wA[3]} + vv2 * (f32x2){k2A[2], k2A[3]}; S1 = pav * (f32x2){bnA[2], bnA[3]} + S1;
                    S2 = S2 * (f32x2){wB[0], wB[1]} + vv2 * (f32x2){k2B[0], k2B[1]}; S2 = pav * (f32x2){bnB[0], bnB[1]} + S2;
                    S3 = S3 * (f32x2){wB[2], wB[3]} + vv2 * (f32x2){k2B[2], k2B[3]}; S3 = pav * (f32x2){bnB[2], bnB[3]} + S3;
                    const float y = py + pa * sc[0] + vv * sc[1];
                    if (kl == 0) yb[tt * 32 + row] = y;
                }
                __syncthreads();
            }
            __syncthreads();
        }
    }
}

__device__ void phase_finalize(const Params& P) {
    unsigned char* ws = P.ws;
    const half_t* Z = (const half_t*)(ws + WS_Z); const half_t* LO = (const half_t*)(ws + WS_LO); const float* BON = (const float*)(ws + WS_BON);
    const float* YR = P.out; half_t* Y = (half_t*)(ws + WS_Y);
    const int lane = threadIdx.x & 63, wv = threadIdx.x >> 6;
    for (int it = blockIdx.x * 8 + wv; it < MTOK * NH; it += gridDim.x * 8) {
        const int m = it >> 3, h = it & 7, hc = h * 64 + lane, t = m & (SEQ - 1);
        const float yv = YR[(size_t)m * 512 + hc];
        const float mean = wave_sum(yv) * (1.0f / 64.0f); const float d = yv - mean;
        const float var = wave_sum(d * d) * (1.0f / 64.0f);
        const float yn = d * __builtin_amdgcn_rsqf(var + GN_EPS) * P.in[14][hc] + P.in[15][hc];
        const float v0 = (float)Z[(size_t)m * NIN + 1024 + hc]; const float vp = t > 0 ? (float)Z[(size_t)(m - 1) * NIN + 1024 + hc] : 0.f;
        const float v = v0 + (vp - v0) * P.in[5][1024 + hc];
        const float g = (float)LO[(size_t)m * 1536 + 1024 + hc];
        const float o = (yn + BON[it] * v) * g;
        Y[(size_t)m * DM + hc] = (half_t)o;
    }
}

__device__ void phase_ln1(const Params& P) {
    half_t* H1 = (half_t*)(P.ws + WS_H1);
    const int lane = threadIdx.x & 63, wv = threadIdx.x >> 6;
    for (int row = blockIdx.x * 8 + wv; row < MTOK; row += gridDim.x * 8) ln_row_to_f16(P.out + (size_t)row * DM, P.in[19], P.in[20], H1 + (size_t)row * DM, lane);
}
__device__ void phase_ln2(const Params& P) {
    const int lane = threadIdx.x & 63, wv = threadIdx.x >> 6;
    const float* g = P.in[26]; const float* b = P.in[27];
    for (int row = blockIdx.x * 8 + wv; row < MTOK; row += gridDim.x * 8) {
        float* xrow = P.out + (size_t)row * DM;
        f32x4 v[4]; float s = 0.f;
#pragma unroll
        for (int j = 0; j < 4; ++j) { v[j] = *(const f32x4*)(xrow + j * 256 + lane * 4); s += (v[j][0] + v[j][1]) + (v[j][2] + v[j][3]); }
        const float mu = wave_sum(s) * (1.0f / 1024.0f); float q = 0.f;
#pragma unroll
        for (int j = 0; j < 4; ++j) { v[j] = v[j] - mu; q += (v[j][0] * v[j][0] + v[j][1] * v[j][1]) + (v[j][2] * v[j][2] + v[j][3] * v[j][3]); }
        const float rstd = __builtin_amdgcn_rsqf(wave_sum(q) * (1.0f / 1024.0f) + LN_EPS);
#pragma unroll
        for (int j = 0; j < 4; ++j) { const f32x4 gg = *(const f32x4*)(g + j * 256 + lane * 4), bb = *(const f32x4*)(b + j * 256 + lane * 4);
            *(f32x4*)(xrow + j * 256 + lane * 4) = v[j] * rstd * gg + bb; }
    }
}

__global__ void __launch_bounds__(NTHREADS) fwd_megakernel(Params P) {
    extern __shared__ __attribute__((aligned(16))) unsigned char lds_raw[];
    LAS unsigned char* lds = (LAS unsigned char*)lds_raw;
    cg::grid_group grid = cg::this_grid();
    unsigned char* ws = P.ws;
    const int lo = P.ph_lo, hi = P.ph_hi, G = gridDim.x, bx = blockIdx.x;
#define IN(k) (lo <= (k) && (k) < hi)
#define SEAM(k) do { if (IN(k) && IN((k) + 1)) grid.sync(); } while (0)
    if (IN(0)) { phase_prologue(lds, P); } SEAM(0);
    if (IN(1)) {
        pg8::Gemm g{(const half_t*)(ws + WS_H0), (const half_t*)(ws + WS_WIN), MTOK, NIN, DM}; pg8::StaticOrder S; S.init(MTOK, NIN, G, bx);
        pg8::EpiH E{(half_t*)(ws + WS_Z), NIN, 0, nullptr};
        pg8::gemm_phase<pg8::EpiH>(lds, g, S, E);
    } SEAM(1);
    if (IN(2)) { phase_prep(P); } SEAM(2);
    if (IN(3)) {
        { pg8::Gemm g{(const half_t*)(ws + WS_AL), (const half_t*)(ws + WS_WLORA), MTOK, 1536, 256}; pg8::StaticOrder S; S.init(MTOK, 1536, G, bx);
            pg8::EpiH E{(half_t*)(ws + WS_LO), 1536, 0, nullptr};
            pg8::gemm_phase<pg8::EpiH>(lds, g, S, E); }
        { pg8::Gemm g{(const half_t*)(ws + WS_DP), (const half_t*)(ws + WS_WPOOL), MTOK, 512, 512}; pg8::StaticOrder S; S.init(MTOK, 512, G, bx);
            pg8::EpiH E{(half_t*)(ws + WS_Y), DM, 512, P.in[17]};
            pg8::gemm_phase<pg8::EpiH>(lds, g, S, E); }
    } SEAM(3);
    if (IN(4)) { phase_scan(lds, P); } SEAM(4);
    if (IN(5)) { phase_finalize(P); } SEAM(5);
    if (IN(6)) {
        pg8::Gemm g{(const half_t*)(ws + WS_Y), (const half_t*)(ws + WS_WOUT), MTOK, DM, DM}; pg8::StaticOrder S; S.init(MTOK, DM, G, bx);
        pg8::EpiRes<false> E{P.out, (const half_t*)(ws + WS_H0), nullptr, DM};
        pg8::gemm_phase<pg8::EpiRes<false>>(lds, g, S, E);
    } SEAM(6);
    if (IN(7)) { phase_ln1(P); } SEAM(7);
    if (IN(8)) {
        { pg8::Gemm g{(const half_t*)(ws + WS_H1), (const half_t*)(ws + WS_WGU), MTOK, 2 * DFF, DM}; pg8::StaticOrder S; S.init(MTOK, 2 * DFF, G, bx);
            pg8::EpiSwiGLU E{(half_t*)(ws + WS_ACT), DFF};
            pg8::gemm_phase<pg8::EpiSwiGLU>(lds, g, S, E); }
        { pg8::Gemm g{(const half_t*)(ws + WS_P16), (const half_t*)(ws + WS_WPLP), MTOK, DM, DPLE}; pg8::StaticOrder S; S.init(MTOK, DM, G, bx);
            pg8::EpiH E{(half_t*)(ws + WS_E2), DM, 0, nullptr};
            pg8::gemm_phase<pg8::EpiH>(lds, g, S, E); }
        { pg8::Gemm g{(const half_t*)(ws + WS_H1), (const half_t*)(ws + WS_WPLG), MTOK, DM, DM}; pg8::StaticOrder S; S.init(MTOK, DM, G, bx);
            pg8::EpiE E{(half_t*)(ws + WS_E2), DM};
            pg8::gemm_phase<pg8::EpiE>(lds, g, S, E); }
    } SEAM(8);
    if (IN(9)) {
        pg8::Gemm g{(const half_t*)(ws + WS_ACT), (const half_t*)(ws + WS_WDN), MTOK, DM, DFF}; pg8::StaticOrder S; S.init(MTOK, DM, G, bx);
        pg8::EpiRes<true> E{P.out, (const half_t*)(ws + WS_H1), (const half_t*)(ws + WS_E2), DM};
        pg8::gemm_phase<pg8::EpiRes<true>>(lds, g, S, E);
    } SEAM(9);
    if (IN(10)) { phase_ln2(P); }
#undef IN
#undef SEAM
}

extern "C" void kernel_launch(void* const* d_in, const int* in_sizes, int n_in, void* d_out, int out_size, void* d_ws, size_t ws_size, hipStream_t stream) {
    static int grid_blocks = 0;
    if (grid_blocks == 0) {
        if (n_in != 28 || out_size != MTOK * DM || ws_size < WS_END) { fprintf(stderr, "kernel_launch: unexpected shapes (n_in %d, out %d, ws %zu, need %zu)\n", n_in, out_size, ws_size, (size_t)WS_END); grid_blocks = -1; return; }
        int dev = 0, cus = 0, per_cu = 0;
        (void)hipGetDevice(&dev);
        (void)hipDeviceGetAttribute(&cus, hipDeviceAttributeMultiprocessorCount, dev);
        if (hipFuncSetAttribute((const void*)fwd_megakernel, hipFuncAttributeMaxDynamicSharedMemorySize, LDS_BYTES) != hipSuccess) { fprintf(stderr, "kernel_launch: hipFuncSetAttribute failed\n"); grid_blocks = -1; return; }
        if (hipOccupancyMaxActiveBlocksPerMultiprocessor(&per_cu, (const void*)fwd_megakernel, NTHREADS, LDS_BYTES) != hipSuccess || per_cu < 1) { fprintf(stderr, "kernel_launch: occupancy query failed (%d)\n", per_cu); per_cu = 1; (void)hipGetLastError(); }
        grid_blocks = cus * per_cu;
    }
    if (grid_blocks < 0) return;
    Params p{};
    for (int i = 0; i < 28; ++i) p.in[i] = (const float*)d_in[i];
    p.out = (float*)d_out; p.ws = (unsigned char*)d_ws;
#if N_LAUNCH_MODE == 1
    p.ph_lo = 0; p.ph_hi = NPHASE;
    { void* args[] = {&p};
        hipError_t e = hipLaunchCooperativeKernel((const void*)fwd_megakernel, dim3(grid_blocks), dim3(NTHREADS), args, LDS_BYTES, stream);
        if (e != hipSuccess) fprintf(stderr, "cooperative launch failed: %s (grid %d)\n", hipGetErrorString(e), grid_blocks); }
#else
    for (int ph = 0; ph < NPHASE; ++ph) {
        p.ph_lo = ph; p.ph_hi = ph + 1;
        void* args[] = {&p};
        hipError_t e = hipLaunchCooperativeKernel((const void*)fwd_megakernel, dim3(grid_blocks), dim3(NTHREADS), args, LDS_BYTES, stream);
        if (e != hipSuccess) { fprintf(stderr, "launch %d failed: %s (grid %d)\n", ph, hipGetErrorString(e), grid_blocks); break; }
    }
#endif
}
```

```cpp
#include <hip/hip_runtime.h>
#include <hip/hip_cooperative_groups.h>
#include <cstdio>
namespace cg = cooperative_groups;

#ifndef N_LAUNCH_MODE
#define N_LAUNCH_MODE 1
#endif

#ifndef PROBE_DUP
#define PROBE_DUP 0
#endif
#define LAS __attribute__((address_space(3)))
typedef _Float16 half_t;
typedef _Float16 h8 __attribute__((ext_vector_type(8)));
typedef _Float16 h4 __attribute__((ext_vector_type(4)));
typedef _Float16 h2 __attribute__((ext_vector_type(2)));
typedef float f32x4 __attribute__((ext_vector_type(4)));
typedef float f32x2 __attribute__((ext_vector_type(2)));
typedef unsigned u32x4 __attribute__((ext_vector_type(4)));
typedef unsigned u32x2 __attribute__((ext_vector_type(2)));
typedef unsigned long long u64x2 __attribute__((ext_vector_type(2)));

constexpr int MTOK = 32768, SEQ = 2048, DM = 1024, NIN = 2304, RWW = 512, DFF = 2816, DPLE = 256, NH = 8;
constexpr float ALPHA = 1.189207115f;
constexpr float LN_EPS = 1e-5f, GN_EPS = 64e-5f;
constexpr int NTHREADS = 512;
constexpr int LDS_BYTES = 131072;
constexpr int LDS_TAB = LDS_BYTES + 64;
constexpr int LDS_TOTAL = LDS_TAB + 10240 + 64;
constexpr int NPHASE = 9;

constexpr size_t MiB = 1024 * 1024;
constexpr size_t WS_WIN = 5 * MiB;
constexpr size_t WS_WOUT = WS_WIN + (size_t)NIN * DM * 2;
constexpr size_t WS_WGU = WS_WOUT + (size_t)DM * DM * 2;
constexpr size_t WS_WDN = WS_WGU + (size_t)2 * DFF * DM * 2;
constexpr size_t WS_WPLG = WS_WDN + (size_t)DM * DFF * 2;
constexpr size_t WS_WPLP = WS_WPLG + (size_t)DM * DM * 2;
constexpr size_t WS_WLORA = WS_WPLP + (size_t)DM * DPLE * 2;
constexpr size_t WS_WPOOL = WS_WLORA + (size_t)1536 * 256 * 2;
constexpr size_t WS_WEND = WS_WPOOL + (size_t)512 * 512 * 2;
static_assert(WS_WEND <= 32 * MiB, "weights region");
constexpr size_t WS_BON = 30 * MiB;
constexpr size_t WS_H0 = 32 * MiB;
constexpr size_t WS_Z = 96 * MiB;
constexpr size_t WS_LO = 240 * MiB;
constexpr size_t WS_AL = 336 * MiB;
constexpr size_t WS_DP = 352 * MiB;
constexpr size_t WS_P16 = 384 * MiB;
constexpr size_t WS_Y = 400 * MiB;
constexpr size_t WS_XB1 = 464 * MiB;
constexpr size_t WS_XB2 = 465 * MiB;
constexpr size_t WS_XS = 128 * 1024;
constexpr size_t XS_BYTES = (size_t)128 * 2 * SEQ * 8;
constexpr size_t WS_END = 498 * MiB;
constexpr size_t CTL_CNT1 = 65536, CTL_CNT2 = 65536 + 32768, CTL_BYTES = 131072;
constexpr size_t WS_H1 = WS_Z;
constexpr size_t WS_ACT = WS_Z + 64 * MiB;
constexpr size_t WS_E2 = WS_Y;
static_assert(WS_ACT + (size_t)MTOK * DFF * 2 <= WS_AL, "ACT alias");

struct Params {
    const float* in[28];
    float* out;
    unsigned char* ws;
    int ph_lo, ph_hi;
};

__device__ __forceinline__ unsigned pk2h(float a, float b) { h2 v; v.x = (_Float16)a; v.y = (_Float16)b; return __builtin_bit_cast(unsigned, v); }
__device__ __forceinline__ float sigm(float x) { return __builtin_amdgcn_rcpf(1.0f + __builtin_amdgcn_exp2f(-1.44269504f * x)); }
template <int CTRL> __device__ __forceinline__ float dpp_get(float v) { return __int_as_float(__builtin_amdgcn_update_dpp(0, __float_as_int(v), CTRL, 0xF, 0xF, false)); }
__device__ __forceinline__ float red8(float v) { v += dpp_get<0xB1>(v); v += dpp_get<0x4E>(v); v += dpp_get<0x141>(v); return v; }
__device__ __forceinline__ float red16(float v) { v = red8(v); v += dpp_get<0x140>(v); return v; }
__device__ __forceinline__ float wave_sum(float v) { v = red16(v); v += __shfl_xor(v, 16); v += __shfl_xor(v, 32); return v; }


#define XB_TMO      128
#define XB_XCNT(j)  (256  + 64 * (j))
#define XB_XSUB(j)  (1280 + 64 * (j))
#define XB_XGEN(j)  (2304 + 64 * (j))
#define XB_TOP      3328
#define XB_TOPGEN   3392
#define XCD_BAR_WORDS 3456
#define XB_SPIN_CAP (1u << 20)
__device__ __forceinline__ unsigned xb_ld(unsigned* p)              { return __hip_atomic_load(p, __ATOMIC_RELAXED, __HIP_MEMORY_SCOPE_AGENT); }
__device__ __forceinline__ unsigned xb_add(unsigned* p, unsigned v) { return __hip_atomic_fetch_add(p, v, __ATOMIC_RELAXED, __HIP_MEMORY_SCOPE_AGENT); }
__device__ __forceinline__ unsigned xb_xcc_id() { return (unsigned)__builtin_amdgcn_s_getreg((3 << 11) | 20) & 0xFu; }
#define XB_SPIN(cond, bar) do { unsigned _sp = 0; while (cond) { __builtin_amdgcn_s_sleep(1); \
    if ((++_sp & 255u) == 0u) { if (xb_ld(&(bar)[XB_TMO])) break; if (_sp > XB_SPIN_CAP) { atomicAdd(&(bar)[XB_TMO], 1u); break; } } } } while (0)
struct XcdBarrier { unsigned* bar; unsigned x; volatile LAS unsigned* st; };
__device__ __forceinline__ XcdBarrier xcd_barrier_post(unsigned* bar, volatile LAS unsigned* st) {
    XcdBarrier b; b.bar = bar; b.x = xb_xcc_id(); b.st = st;
    if (threadIdx.x == 0) (void)xb_add(&bar[XB_XCNT(b.x)], 1u);
    return b;
}
__device__ __forceinline__ void xcd_barrier_complete(unsigned* bar, unsigned x, unsigned& nloc, unsigned& nx) {
    const unsigned G = gridDim.x * gridDim.y * gridDim.z;
    unsigned sum, cnt, mine, sp = 0u;
    for (;;) {
        sum = 0u; cnt = 0u; mine = 0u;
#pragma unroll
        for (unsigned j = 0; j < 16; ++j) { const unsigned c = xb_ld(&bar[XB_XCNT(j)]); sum += c; cnt += (c > 0u) ? 1u : 0u; mine = (j == x) ? c : mine; }
        if (sum == G) break;
        __builtin_amdgcn_s_sleep(1);
        if ((++sp & 255u) == 0u) { if (xb_ld(&bar[XB_TMO])) break; if (sp > XB_SPIN_CAP) { atomicAdd(&bar[XB_TMO], 1u); break; } }
    }
    nloc = mine > 0u ? mine : 1u; nx = cnt > 0u ? cnt : 1u;
}
__device__ __forceinline__ void xcd_barrier(const XcdBarrier& b) {
    asm volatile("s_waitcnt vmcnt(0)" ::: "memory");
    __syncthreads();
    if (threadIdx.x == 0) {
        unsigned* bar = b.bar;
        __builtin_amdgcn_s_waitcnt(0);
        unsigned nloc = b.st[0], nx = b.st[1];
        if (nloc == 0u) { xcd_barrier_complete(bar, b.x, nloc, nx); b.st[0] = nloc; b.st[1] = nx; }
        const unsigned old = xb_add(&bar[XB_XSUB(b.x)], 1u);
        const unsigned gen = old / nloc;
        if (old + 1u == (gen + 1u) * nloc) {
            __builtin_amdgcn_fence(__ATOMIC_RELEASE, "agent");
            asm volatile("s_waitcnt vmcnt(0)" ::: "memory");
            const unsigned og = xb_add(&bar[XB_TOP], 1u);
            const unsigned tg = og / nx;
            if (og + 1u == (tg + 1u) * nx) xb_add(&bar[XB_TOPGEN], 1u);
            else XB_SPIN(xb_ld(&bar[XB_TOPGEN]) == tg, bar);
            __builtin_amdgcn_fence(__ATOMIC_ACQUIRE, "agent");
            xb_add(&bar[XB_XGEN(b.x)], 1u);
            asm volatile("s_waitcnt vmcnt(0)" ::: "memory");
        } else {
            XB_SPIN(xb_ld(&bar[XB_XGEN(b.x)]) == gen, bar);
            __builtin_amdgcn_fence(__ATOMIC_ACQUIRE, "agent");
            asm volatile("s_waitcnt vmcnt(0)" ::: "memory");
        }
    }
    __syncthreads();
}

namespace pg8 {
constexpr int BM = 256, BK = 64, HALF = 128, HTB = HALF * BK * 2, STAGE_BYTES = 8 * HTB, NXCD = 8, WGM = 8;
__device__ __forceinline__ int lds_byte(int r, int c) { const int st = (r >> 4) * 2 + (c >> 5), rr = r & 15, cc = c & 31, ob = rr * 64 + cc * 2; return st * 1024 + (ob ^ (((ob >> 9) & 1) << 5)); }
__device__ __forceinline__ void stage_rc(int b, int& R, int& C) { const int st = b / 1024, sb = b % 1024, swz = sb ^ (((sb >> 9) & 1) << 5); R = (st >> 1) * 16 + swz / 64; C = (st & 1) * 32 + (swz % 64) / 2; }
__device__ __forceinline__ int perm32(int rho) { const int n = rho >> 4, i = rho & 15; return 8 * (i >> 2) + 4 * n + (i & 3); }

struct Unit { int pm, pn; };
struct Gemm { const half_t* A; const half_t* Bt; int M, N, K; };
struct StaticOrder {
    int nM, nN, nwg, G, c;
    __device__ void init(int M, int N, int G_, int c_) { nM = M / BM; nN = N / BM; nwg = nM * nN; G = G_; c = c_; }
    __device__ bool next(int i, Unit& u) const {
        const long L = (long)i * G + c; if (L >= nwg) return false;
        int wgid = (int)L; { const int q = nwg / NXCD, r = nwg % NXCD, xcd = wgid % NXCD, off = wgid / NXCD; wgid = (xcd < r ? xcd * (q + 1) : r * (q + 1) + (xcd - r) * q) + off; }
        const int nig = WGM * nN, gid = wgid / nig, fm = gid * WGM, gsz = (nM - fm) < WGM ? (nM - fm) : WGM;
        u.pm = fm + ((wgid % nig) % gsz); u.pn = (wgid % nig) / gsz; return true;
    }
};


struct EpiH {
    static constexpr bool PERM = true, SYNC = false;
    half_t* O; int ldc; int coff; const float* scale;
    __device__ __forceinline__ void operator()(const f32x4 (&acc)[2][2][4][2], const Unit& u, int wr, int wc, int fr, int fq) const {
        const int row0 = u.pm * BM + wr * 64 + fr, col0 = u.pn * BM + wc * 32 + 8 * fq;
        f32x4 sv[2][2];
#pragma unroll
        for (int bj = 0; bj < 2; ++bj)
#pragma unroll
            for (int n = 0; n < 2; ++n) sv[bj][n] = scale ? *(const f32x4*)(scale + col0 + bj * HALF + 4 * n) : (f32x4){1.f, 1.f, 1.f, 1.f};
#pragma unroll
        for (int ai = 0; ai < 2; ++ai)
#pragma unroll
            for (int m = 0; m < 4; ++m) { half_t* rowp = O + (size_t)(row0 + ai * HALF + m * 16) * ldc + coff + col0;
#pragma unroll
                for (int bj = 0; bj < 2; ++bj) { const f32x4 v0 = acc[ai][bj][m][0] * sv[bj][0], v1 = acc[ai][bj][m][1] * sv[bj][1];
                    u32x4 w; w.x = pk2h(v0[0], v0[1]); w.y = pk2h(v0[2], v0[3]); w.z = pk2h(v1[0], v1[1]); w.w = pk2h(v1[2], v1[3]);
                    *(u32x4*)(rowp + bj * HALF) = w; } }
    }
};
struct EpiSwiGLU {
    static constexpr bool PERM = true, SYNC = false;
    half_t* O; int ldc;
    __device__ __forceinline__ void operator()(const f32x4 (&acc)[2][2][4][2], const Unit& u, int wr, int wc, int fr, int fq) const {
        const int row0 = u.pm * BM + wr * 64 + fr, col0 = u.pn * HALF + wc * 32 + 8 * fq;
#pragma unroll
        for (int ai = 0; ai < 2; ++ai)
#pragma unroll
            for (int m = 0; m < 4; ++m) { half_t* rowp = O + (size_t)(row0 + ai * HALF + m * 16) * ldc + col0;
                float r[8];
#pragma unroll
                for (int n = 0; n < 2; ++n)
#pragma unroll
                    for (int j = 0; j < 4; ++j) { const float g = acc[ai][0][m][n][j], up = acc[ai][1][m][n][j]; r[n * 4 + j] = g * sigm(g) * up; }
                u32x4 w; w.x = pk2h(r[0], r[1]); w.y = pk2h(r[2], r[3]); w.z = pk2h(r[4], r[5]); w.w = pk2h(r[6], r[7]);
                *(u32x4*)rowp = w; }
    }
};
struct EpiE {
    static constexpr bool PERM = true, SYNC = false;
    half_t* E; int ldc;
    __device__ __forceinline__ void operator()(const f32x4 (&acc)[2][2][4][2], const Unit& u, int wr, int wc, int fr, int fq) const {
        const int row0 = u.pm * BM + wr * 64 + fr, col0 = u.pn * BM + wc * 32 + 8 * fq;
#pragma unroll
        for (int ai = 0; ai < 2; ++ai)
#pragma unroll
            for (int m = 0; m < 4; ++m) { half_t* rowp = E + (size_t)(row0 + ai * HALF + m * 16) * ldc + col0;
#pragma unroll
                for (int bj = 0; bj < 2; ++bj) {
                    const unsigned long long* ep = (const unsigned long long*)(rowp + bj * HALF);
                    u64x2 e01; e01.x = __hip_atomic_load(ep, __ATOMIC_RELAXED, __HIP_MEMORY_SCOPE_AGENT); e01.y = __hip_atomic_load(ep + 1, __ATOMIC_RELAXED, __HIP_MEMORY_SCOPE_AGENT);
                    const h8 e = __builtin_bit_cast(h8, e01); float r[8];
#pragma unroll
                    for (int n = 0; n < 2; ++n)
#pragma unroll
                        for (int j = 0; j < 4; ++j) r[n * 4 + j] = sigm(acc[ai][bj][m][n][j]) * (float)e[n * 4 + j];
                    u32x4 w; w.x = pk2h(r[0], r[1]); w.y = pk2h(r[2], r[3]); w.z = pk2h(r[4], r[5]); w.w = pk2h(r[6], r[7]);
                    *(u32x4*)(rowp + bj * HALF) = w; } }
    }
};
template <bool HAS2> struct EpiRes {
    static constexpr bool PERM = false, SYNC = false;
    float* C; const half_t* R1; const half_t* R2; int ldc;
    __device__ __forceinline__ void operator()(const f32x4 (&acc)[2][2][4][2], const Unit& u, int wr, int wc, int fr, int fq) const {
        const int row0 = u.pm * BM + wr * 64 + fr, col0 = u.pn * BM + wc * 32 + 4 * fq;
#pragma unroll
        for (int ai = 0; ai < 2; ++ai)
#pragma unroll
            for (int m = 0; m < 4; ++m) { const size_t off = (size_t)(row0 + ai * HALF + m * 16) * ldc + col0;
#pragma unroll
                for (int bj = 0; bj < 2; ++bj)
#pragma unroll
                    for (int n = 0; n < 2; ++n) { const size_t o = off + bj * HALF + n * 16; const h4 a = *(const h4*)(R1 + o);
                        f32x4 v = acc[ai][bj][m][n]; v[0] += ALPHA * (float)a[0]; v[1] += ALPHA * (float)a[1]; v[2] += ALPHA * (float)a[2]; v[3] += ALPHA * (float)a[3];
                        if (HAS2) { const h4 e = *(const h4*)(R2 + o); v[0] += (float)e[0]; v[1] += (float)e[1]; v[2] += (float)e[2]; v[3] += (float)e[3]; }
                        *(f32x4*)(C + o) = v; } }
    }
};


struct PanelStats {
    unsigned long long* xbuf; unsigned* cnt; float eps;
    __device__ __forceinline__ void run(const f32x4 (&v)[2][2][4][2], const Unit& u, int wr, int wc, int fr, int fq, LAS unsigned char* tl, int wid, int lane) const {
        LAS f32x2* Pt = (LAS f32x2*)tl; LAS f32x2* St = (LAS f32x2*)(tl + 8192);
#pragma unroll
        for (int ai = 0; ai < 2; ++ai)
#pragma unroll
            for (int m = 0; m < 4; ++m) {
                float s = 0.f;
#pragma unroll
                for (int bj = 0; bj < 2; ++bj)
#pragma unroll
                    for (int n = 0; n < 2; ++n) { const f32x4 x = v[ai][bj][m][n]; s += (x[0] + x[1]) + (x[2] + x[3]); }
                s += __shfl_xor(s, 16); s += __shfl_xor(s, 32);
                const float mw = s * (1.0f / 64.0f); float q = 0.f;
#pragma unroll
                for (int bj = 0; bj < 2; ++bj)
#pragma unroll
                    for (int n = 0; n < 2; ++n) { const f32x4 d = v[ai][bj][m][n] - mw; q += (d[0] * d[0] + d[1] * d[1]) + (d[2] * d[2] + d[3] * d[3]); }
                q += __shfl_xor(q, 16); q += __shfl_xor(q, 32);
                if (fq == 0) Pt[(ai * HALF + wr * 64 + m * 16 + fr) * 4 + wc] = (f32x2){mw, q};
            }
        asm volatile("s_waitcnt lgkmcnt(0)" ::: "memory"); __builtin_amdgcn_s_barrier(); asm volatile("" ::: "memory");
        const int row = wid * 32 + (lane & 31);
        if (lane < 32) {
            const f32x2 a = Pt[row * 4 + 0], b = Pt[row * 4 + 1], c = Pt[row * 4 + 2], d = Pt[row * 4 + 3];
            const float mt = (a.x + b.x + c.x + d.x) * 0.25f;
            const float da = a.x - mt, db = b.x - mt, dc = c.x - mt, dd = d.x - mt;
            const float m2 = (a.y + b.y) + (c.y + d.y) + 64.0f * ((da * da + db * db) + (dc * dc + dd * dd));
            unsigned long long* slot = xbuf + ((size_t)(u.pm * BM + row) * 4 + u.pn);
            __hip_atomic_store(slot, ((unsigned long long)__float_as_uint(m2) << 32) | __float_as_uint(mt), __ATOMIC_RELAXED, __HIP_MEMORY_SCOPE_AGENT);
        }
        asm volatile("s_waitcnt vmcnt(0)" ::: "memory");
        if (lane == 0) __hip_atomic_fetch_add(cnt + 64 * u.pm, 1u, __ATOMIC_RELAXED, __HIP_MEMORY_SCOPE_AGENT);
        if (wid == 0) {
            unsigned sp = 0;
            while ((unsigned)__builtin_amdgcn_readfirstlane(__hip_atomic_load(cnt + 64 * u.pm, __ATOMIC_RELAXED, __HIP_MEMORY_SCOPE_AGENT)) < 32u) { __builtin_amdgcn_s_sleep(2); if (++sp > (1u << 22)) break; }
            __builtin_amdgcn_fence(__ATOMIC_ACQUIRE, "agent");
        }
        asm volatile("s_waitcnt vmcnt(0) lgkmcnt(0)" ::: "memory"); __builtin_amdgcn_s_barrier(); asm volatile("" ::: "memory");
        if (lane < 32) {
            const unsigned long long* slot = xbuf + (size_t)(u.pm * BM + row) * 4; float mt[4], m2[4]; float ms = 0.f;
#pragma unroll
            for (int t = 0; t < 4; ++t) { const unsigned long long w = __hip_atomic_load(slot + t, __ATOMIC_RELAXED, __HIP_MEMORY_SCOPE_AGENT); mt[t] = __uint_as_float((unsigned)w); m2[t] = __uint_as_float((unsigned)(w >> 32)); ms += mt[t]; }
            const float mean = ms * 0.25f; float q = 0.f;
#pragma unroll
            for (int t = 0; t < 4; ++t) { const float dm = mt[t] - mean; q += m2[t] + 256.0f * dm * dm; }
            St[row] = (f32x2){mean, __builtin_amdgcn_rsqf(q * (1.0f / 1024.0f) + eps)};
        }
        asm volatile("s_waitcnt lgkmcnt(0)" ::: "memory"); __builtin_amdgcn_s_barrier(); asm volatile("" ::: "memory");
    }
};
template <bool FINAL> struct EpiLN {
    static constexpr bool PERM = false, SYNC = true;
    const half_t* R1; const half_t* R2; const float* g; const float* b; half_t* H; float* C; PanelStats st; LAS unsigned char* tl;
    __device__ __forceinline__ void operator()(f32x4 (&acc)[2][2][4][2], const Unit& u, int wr, int wc, int fr, int fq) const {
        const int lane = threadIdx.x & 63, wid = __builtin_amdgcn_readfirstlane(threadIdx.x >> 6);
        const int row0 = u.pm * BM + wr * 64 + fr, col0 = u.pn * BM + wc * 32 + 4 * fq;
#pragma unroll
        for (int ai = 0; ai < 2; ++ai)
#pragma unroll
            for (int m = 0; m < 4; ++m) { const size_t off = (size_t)(row0 + ai * HALF + m * 16) * DM + col0;
#pragma unroll
                for (int bj = 0; bj < 2; ++bj)
#pragma unroll
                    for (int n = 0; n < 2; ++n) { const size_t o = off + bj * HALF + n * 16; const h4 a = *(const h4*)(R1 + o);
                        f32x4 v = acc[ai][bj][m][n]; v[0] += ALPHA * (float)a[0]; v[1] += ALPHA * (float)a[1]; v[2] += ALPHA * (float)a[2]; v[3] += ALPHA * (float)a[3];
                        if (FINAL) { const h4 e = *(const h4*)(R2 + o); v[0] += (float)e[0]; v[1] += (float)e[1]; v[2] += (float)e[2]; v[3] += (float)e[3]; }
                        acc[ai][bj][m][n] = v; }
                asm volatile("" : "+v"(acc[ai][0][m][0]), "+v"(acc[ai][0][m][1]), "+v"(acc[ai][1][m][0]), "+v"(acc[ai][1][m][1]));
                asm volatile("" ::: "memory"); }
        f32x4 gvv[2][2], bvv[2][2];
#pragma unroll
        for (int bj = 0; bj < 2; ++bj)
#pragma unroll
            for (int n = 0; n < 2; ++n) { gvv[bj][n] = *(const f32x4*)(g + col0 + bj * HALF + n * 16); bvv[bj][n] = *(const f32x4*)(b + col0 + bj * HALF + n * 16); }
        st.run(acc, u, wr, wc, fr, fq, tl, wid, lane);
        const LAS f32x2* St = (const LAS f32x2*)(tl + 8192);
#pragma unroll
        for (int ai = 0; ai < 2; ++ai)
#pragma unroll
            for (int m = 0; m < 4; ++m) { const int r = ai * HALF + wr * 64 + m * 16 + fr; const f32x2 sr = St[r]; const size_t off = (size_t)(u.pm * BM + r) * DM + col0;
#pragma unroll
                for (int bj = 0; bj < 2; ++bj)
#pragma unroll
                    for (int n = 0; n < 2; ++n) {
                        const f32x4 o = (acc[ai][bj][m][n] - sr.x) * sr.y * gvv[bj][n] + bvv[bj][n]; const size_t oo = off + bj * HALF + n * 16;
                        if (FINAL) *(f32x4*)(C + oo) = o;
                        else { u32x2 w; w.x = pk2h(o[0], o[1]); w.y = pk2h(o[2], o[3]); *(u32x2*)(H + oo) = w; } }
                asm volatile("" ::: "memory"); }
        asm volatile("s_waitcnt lgkmcnt(0)" ::: "memory"); __builtin_amdgcn_s_barrier(); asm volatile("" ::: "memory");
    }
};

template <class Epi>
__device__ __forceinline__ void gemm_phase(LAS unsigned char* lds, const Gemm g, const StaticOrder& S, const Epi& E) {
    const int tid = threadIdx.x, wid = __builtin_amdgcn_readfirstlane(tid >> 6), lane = tid & 63, wr = wid >> 2, wc = wid & 3, fr = lane & 15, fq = lane >> 4;
    const int K = g.K, nt = K / BK;
    unsigned voffA[2], voffB[2];
#pragma unroll
    for (int i = 0; i < 2; ++i) { int R, C; stage_rc(tid * 16 + i * 8192, R, C); const int Rb = Epi::PERM ? ((R & ~31) + perm32(R & 31)) : R;
        voffA[i] = (unsigned)(R * K + C) * 2u; voffB[i] = (unsigned)(Rb * K + C) * 2u; }
    const size_t kstep = (size_t)(BK * 2);
    const size_t hstep = (size_t)HALF * K * 2;
    const size_t tstep = 2 * hstep;
    const unsigned ldsw = (unsigned)wid * 1024u;
    const int aoff = lds_byte(wr * 64 + fr, fq * 8), boff = lds_byte(wc * 32 + fr, fq * 8);
#define PG8_SA(b, h) (((b) * 2 + (h)) * HTB)
#define PG8_SB(b, h) ((4 + (b) * 2 + (h)) * HTB)
#define PG8_STAGE(bufoff, gbase, voff) do { _Pragma("unroll") for (int _i = 0; _i < 2; ++_i) \
        __builtin_amdgcn_global_load_lds((const unsigned*)((const char*)(gbase) + (voff)[_i]), (LAS unsigned*)(lds + (bufoff) + ldsw + _i * 8192), 16, 0, 0); } while (0)
#define PG8_LDA(dst, b, h) do { _Pragma("unroll") for (int m = 0; m < 4; ++m) _Pragma("unroll") for (int k = 0; k < 2; ++k) dst[m][k] = *(const LAS h8*)(lds + PG8_SA(b, h) + aoff + m * 2048 + k * 1024); } while (0)
#define PG8_LDB(dst, b, h) do { _Pragma("unroll") for (int n = 0; n < 2; ++n) _Pragma("unroll") for (int k = 0; k < 2; ++k) dst[n][k] = *(const LAS h8*)(lds + PG8_SB(b, h) + boff + n * 2048 + k * 1024); } while (0)
#define PG8_MMA(ai, bj, At, Bt) do { __builtin_amdgcn_s_setprio(1); _Pragma("unroll") for (int m = 0; m < 4; ++m) _Pragma("unroll") for (int n = 0; n < 2; ++n) _Pragma("unroll") for (int k = 0; k < 2; ++k) \
        acc[ai][bj][m][n] = __builtin_amdgcn_mfma_f32_16x16x32_f16(Bt[n][k], At[m][k], acc[ai][bj][m][n], 0, 0, 0); __builtin_amdgcn_s_setprio(0); } while (0)
#define PG8_WAIT_V(n) asm volatile("s_waitcnt vmcnt(" #n ")" ::: "memory")
#define PG8_WAIT_L(n) asm volatile("s_waitcnt lgkmcnt(" #n ")" ::: "memory")
#define PG8_BAR __builtin_amdgcn_s_barrier()
#define PG8_SCHED __builtin_amdgcn_sched_barrier(0)
    Unit cur, nxt; int ui = 0;
    if (!S.next(0, cur)) return;
    f32x4 acc[2][2][4][2];
#pragma unroll
    for (int a = 0; a < 2; ++a)
#pragma unroll
        for (int b = 0; b < 2; ++b)
#pragma unroll
            for (int m = 0; m < 4; ++m)
#pragma unroll
                for (int n = 0; n < 2; ++n) acc[a][b][m][n] = (f32x4){0.f, 0.f, 0.f, 0.f};
    h8 At[4][2], B0[2][2], B1[2][2];
    const char* cA = (const char*)g.A + (size_t)cur.pm * tstep; const char* cB = (const char*)g.Bt + (size_t)cur.pn * tstep;
    PG8_STAGE(PG8_SB(0, 0), cB, voffB); PG8_STAGE(PG8_SB(0, 1), cB + hstep, voffB); PG8_STAGE(PG8_SA(0, 0), cA, voffA); PG8_STAGE(PG8_SA(0, 1), cA + hstep, voffA);
    if (wr == 1) PG8_BAR;
    PG8_WAIT_V(2); PG8_BAR;
    PG8_STAGE(PG8_SB(1, 0), cB + kstep, voffB); PG8_STAGE(PG8_SA(1, 0), cA + kstep, voffA); PG8_STAGE(PG8_SB(1, 1), cB + hstep + kstep, voffB);
    PG8_WAIT_V(6); PG8_BAR;
    for (;;) {
        const bool has_next = S.next(ui + 1, nxt);
        const char* nA = has_next ? (const char*)g.A + (size_t)nxt.pm * tstep : cA; const char* nB = has_next ? (const char*)g.Bt + (size_t)nxt.pn * tstep : cB;
        for (int t = 0; t < nt; t += 2) {
            const bool last = (t == nt - 2);
            const char* a1 = cA + (size_t)(t + 1) * kstep;
            const char* a2 = last ? nA : cA + (size_t)(t + 2) * kstep; const char* b2 = last ? nB : cB + (size_t)(t + 2) * kstep;
            const char* a3 = a2 + kstep; const char* b3 = b2 + kstep;
            PG8_LDB(B0, 0, 0); PG8_LDB(B1, 0, 1); PG8_SCHED; PG8_LDA(At, 0, 0); PG8_STAGE(PG8_SA(1, 1), a1 + hstep, voffA);
            PG8_WAIT_V(8); PG8_WAIT_L(0); PG8_BAR; PG8_MMA(0, 0, At, B0); PG8_MMA(0, 1, At, B1); PG8_BAR; PG8_SCHED;
            PG8_LDA(At, 0, 1); PG8_STAGE(PG8_SB(0, 0), b2, voffB); PG8_STAGE(PG8_SB(0, 1), b2 + hstep, voffB); PG8_STAGE(PG8_SA(0, 0), a2, voffA);
            PG8_WAIT_V(8); PG8_WAIT_L(0); PG8_BAR; PG8_MMA(1, 0, At, B0); PG8_MMA(1, 1, At, B1); PG8_BAR; PG8_SCHED;
            PG8_LDB(B0, 1, 0); PG8_LDB(B1, 1, 1); PG8_SCHED; PG8_LDA(At, 1, 0); PG8_STAGE(PG8_SA(0, 1), a2 + hstep, voffA);
            PG8_WAIT_V(8); PG8_WAIT_L(0); PG8_BAR; PG8_MMA(0, 0, At, B0); PG8_MMA(0, 1, At, B1); PG8_BAR; PG8_SCHED;
            PG8_LDA(At, 1, 1); PG8_STAGE(PG8_SB(1, 0), b3, voffB); PG8_STAGE(PG8_SB(1, 1), b3 + hstep, voffB); PG8_STAGE(PG8_SA(1, 0), a3, voffA);
            PG8_WAIT_V(8); PG8_WAIT_L(0); PG8_BAR; PG8_MMA(1, 0, At, B0); PG8_MMA(1, 1, At, B1); PG8_BAR; PG8_SCHED;
        }
        if (wr == 0) PG8_BAR;
        E(acc, cur, wr, wc, fr, fq);
        if (wr == 1) PG8_BAR;
        if (!has_next) break;
#pragma unroll
        for (int a = 0; a < 2; ++a)
#pragma unroll
            for (int b = 0; b < 2; ++b)
#pragma unroll
                for (int m = 0; m < 4; ++m)
#pragma unroll
                    for (int n = 0; n < 2; ++n) acc[a][b][m][n] = (f32x4){0.f, 0.f, 0.f, 0.f};
        cur = nxt; cA = nA; cB = nB; ++ui;
    }
    PG8_WAIT_V(0);
    if (wr == 0) PG8_BAR;
    PG8_BAR;
#undef PG8_SA
#undef PG8_SB
#undef PG8_STAGE
#undef PG8_LDA
#undef PG8_LDB
#undef PG8_MMA
#undef PG8_WAIT_V
#undef PG8_WAIT_L
#undef PG8_BAR
#undef PG8_SCHED
}
}

__device__ __forceinline__ void transpose_tile(LAS float* tile, const float* __restrict__ src, int N, int k0, int n0, half_t* __restrict__ dst, int ldd, int drow0) {
    const int tid = threadIdx.x;
#pragma unroll
    for (int i = 0; i < 8; ++i) { const int kk = i * 8 + (tid >> 6), nn = tid & 63; tile[kk * 65 + nn] = src[(size_t)(k0 + kk) * N + n0 + nn]; }
    __syncthreads();
    { const int n = tid >> 3, kq = tid & 7; float v[8];
#pragma unroll
        for (int j = 0; j < 8; ++j) v[j] = tile[(kq * 8 + j) * 65 + n];
        u32x4 w; w.x = pk2h(v[0], v[1]); w.y = pk2h(v[2], v[3]); w.z = pk2h(v[4], v[5]); w.w = pk2h(v[6], v[7]);
        *(u32x4*)(dst + (size_t)(drow0 + n) * ldd + k0 + kq * 8) = w; }
    __syncthreads();
}

__device__ __forceinline__ void ln_row_to_f16(const float* __restrict__ xrow, const float* __restrict__ g, const float* __restrict__ b, half_t* __restrict__ orow, int lane) {
    f32x4 v[4]; float s = 0.f;
#pragma unroll
    for (int j = 0; j < 4; ++j) { v[j] = *(const f32x4*)(xrow + j * 256 + lane * 4); s += (v[j][0] + v[j][1]) + (v[j][2] + v[j][3]); }
    const float mu = wave_sum(s) * (1.0f / 1024.0f); float q = 0.f;
#pragma unroll
    for (int j = 0; j < 4; ++j) { v[j] = v[j] - mu; q += (v[j][0] * v[j][0] + v[j][1] * v[j][1]) + (v[j][2] * v[j][2] + v[j][3] * v[j][3]); }
    const float rstd = __builtin_amdgcn_rsqf(wave_sum(q) * (1.0f / 1024.0f) + LN_EPS);
#pragma unroll
    for (int j = 0; j < 4; ++j) { const f32x4 gg = *(const f32x4*)(g + j * 256 + lane * 4), bb = *(const f32x4*)(b + j * 256 + lane * 4); const f32x4 o = v[j] * rstd * gg + bb;
        u32x2 w; w.x = pk2h(o[0], o[1]); w.y = pk2h(o[2], o[3]); *(u32x2*)(orow + j * 256 + lane * 4) = w; }
}

__device__ void phase_prologue(LAS unsigned char* lds, const Params& P) {
    unsigned char* ws = P.ws;
    const int tid = threadIdx.x, G = gridDim.x, bx = blockIdx.x;
    LAS float* tile = (LAS float*)lds;
    const int T0 = 16 * 28, T1 = T0 + 16 * 16, T2 = T1 + 16 * 44, T3 = T2 + 16 * 44, T4 = T3 + 44 * 16, T5 = T4 + 16 * 16, T6 = T5 + 4 * 16;
    for (int t = bx; t < T0; t += G) {
        const float* src; int N, loc, ldd, kind = 0, ncols = 0; half_t* dst;
        if (t < T0) { src = P.in[4]; N = NIN; ncols = 1792; loc = t; dst = (half_t*)(ws + WS_WIN); ldd = DM; }
        else if (t < T1) { src = P.in[18]; N = DM; loc = t - T0; dst = (half_t*)(ws + WS_WOUT); ldd = DM; }
        else if (t < T2) { src = P.in[21]; N = DFF; loc = t - T1; dst = (half_t*)(ws + WS_WGU); ldd = DM; kind = 1; }
        else if (t < T3) { src = P.in[22]; N = DFF; loc = t - T2; dst = (half_t*)(ws + WS_WGU); ldd = DM; kind = 2; }
        else if (t < T4) { src = P.in[23]; N = DM; loc = t - T3; dst = (half_t*)(ws + WS_WDN); ldd = DFF; }
        else if (t < T5) { src = P.in[25]; N = DM; loc = t - T4; dst = (half_t*)(ws + WS_WPLG); ldd = DM; }
        else { src = P.in[24]; N = DM; loc = t - T5; dst = (half_t*)(ws + WS_WPLP); ldd = DPLE; }
        const int ntn = (ncols ? ncols : N) / 64, kt = loc / ntn, nt_ = loc % ntn, n0 = nt_ * 64;
        int drow0 = n0;
        if (kind) drow0 = (n0 >> 7) * 256 + (n0 & 127) + (kind == 2 ? 128 : 0);
        transpose_tile(tile, src, N, kt * 64, n0, dst, ldd, drow0);
    }
    const int gtid = bx * NTHREADS + tid, gth = G * NTHREADS;
    { half_t* wl = (half_t*)(ws + WS_WLORA);
        for (int i = gtid; i < 1536 * 256; i += gth) { const int n = i >> 8, k = i & 255; float v = 0.f;
            if (n < 512) { if (k < 64) v = P.in[7][k * 512 + n]; }
            else if (n < 1024) { if (k >= 64 && k < 128) v = P.in[9][(k - 64) * 512 + (n - 512)]; }
            else { if (k >= 128) v = P.in[10][(k - 128) * 512 + (n - 1024)]; }
            wl[i] = (half_t)v; } }
    { half_t* wt_in = (half_t*)(ws + WS_WIN); LAS float* Pw = (LAS float*)lds; LAS float* Wl = (LAS float*)(lds + 65536);
        for (int job = bx; job < 256; job += G) {
            const int g = job >> 6, k0 = (job & 63) * 16;
            __syncthreads();
            for (int i = tid; i < 4096; i += NTHREADS) *(LAS f32x4*)(Pw + i * 4) = *(const f32x4*)(P.in[16] + (size_t)g * 16384 + i * 4);
            { const int r = tid >> 5, c4 = (tid & 31) * 4; *(LAS f32x4*)(Wl + r * 128 + c4) = *(const f32x4*)(P.in[4] + (size_t)(k0 + r) * NIN + 1792 + g * 128 + c4); }
            __syncthreads();
            const int d = tid & 127, kr = tid >> 7; float acc[4] = {0.f, 0.f, 0.f, 0.f};
#pragma unroll 4
            for (int c = 0; c < 128; c += 4) {
                const float p0 = Pw[c * 128 + d], p1 = Pw[(c + 1) * 128 + d], p2 = Pw[(c + 2) * 128 + d], p3 = Pw[(c + 3) * 128 + d];
#pragma unroll
                for (int j = 0; j < 4; ++j) { const f32x4 wv = *(const LAS f32x4*)(Wl + (kr * 4 + j) * 128 + c); acc[j] += wv[0] * p0 + wv[1] * p1 + wv[2] * p2 + wv[3] * p3; } }
            u32x2 w; w.x = pk2h(acc[0], acc[1]); w.y = pk2h(acc[2], acc[3]);
            *(u32x2*)(wt_in + (size_t)(1792 + g * 128 + d) * DM + k0 + kr * 4) = w;
        }
        __syncthreads(); }
    { u32x4* xz = (u32x4*)(ws + WS_XS); for (int i = bx * NTHREADS + tid; i < (int)(XS_BYTES / 16); i += G * NTHREADS) xz[i] = (u32x4){0u, 0u, 0u, 0u}; }
    { const int lane = tid & 63, wv = tid >> 6; half_t* h0 = (half_t*)(ws + WS_H0);
        f32x4 gg[4], bb[4];
#pragma unroll
        for (int j = 0; j < 4; ++j) { gg[j] = *(const f32x4*)(P.in[2] + j * 256 + lane * 4); bb[j] = *(const f32x4*)(P.in[3] + j * 256 + lane * 4); }
        for (int row = (bx * 8 + wv) * 2; row < MTOK; row += G * 16) {
            f32x4 v[2][4];
#pragma unroll
            for (int r = 0; r < 2; ++r)
#pragma unroll
                for (int j = 0; j < 4; ++j) v[r][j] = __builtin_nontemporal_load((const f32x4*)(P.in[0] + (size_t)(row + r) * DM + j * 256 + lane * 4));
#pragma unroll
            for (int r = 0; r < 2; ++r) {
                float s_ = 0.f;
#pragma unroll
                for (int j = 0; j < 4; ++j) s_ += (v[r][j][0] + v[r][j][1]) + (v[r][j][2] + v[r][j][3]);
                const float mu = wave_sum(s_) * (1.0f / 1024.0f); float q = 0.f;
#pragma unroll
                for (int j = 0; j < 4; ++j) { v[r][j] = v[r][j] - mu; q += (v[r][j][0] * v[r][j][0] + v[r][j][1] * v[r][j][1]) + (v[r][j][2] * v[r][j][2] + v[r][j][3] * v[r][j][3]); }
                const float rstd = __builtin_amdgcn_rsqf(wave_sum(q) * (1.0f / 1024.0f) + LN_EPS);
#pragma unroll
                for (int j = 0; j < 4; ++j) { const f32x4 o = v[r][j] * rstd * gg[j] + bb[j]; u32x2 w; w.x = pk2h(o[0], o[1]); w.y = pk2h(o[2], o[3]); *(u32x2*)(h0 + (size_t)(row + r) * DM + j * 256 + lane * 4) = w; }
            }
        }
    }
}

template <int W> __device__ __forceinline__ void pool_group(const half_t* __restrict__ Z, half_t* __restrict__ Y, const float* __restrict__ scale, int g, int gtid, int gth) {
    for (int i = gtid; i < MTOK * 16; i += gth) {
        const int m = i >> 4, jc = g * 16 + (i & 15), t = m & (SEQ - 1);
        const half_t* zp = Z + (size_t)m * NIN + 1792 + jc * 8;
        h8 u[W];
#pragma unroll
        for (int q = 0; q < W; ++q) { if (q <= t) u[q] = *(const h8*)(zp - (size_t)q * NIN); else u[q] = (h8){0, 0, 0, 0, 0, 0, 0, 0}; }
        const int cnt = (t + 1) < W ? (t + 1) : W; const float inv = 1.0f / (float)cnt; float r[8];
#pragma unroll
        for (int e = 0; e < 8; ++e) { float s = 0.f;
#pragma unroll
            for (int q = 0; q < W; ++q) s += (float)u[q][e];
            r[e] = (s * inv - (float)u[0][e]) * scale[jc * 8 + e]; }
        u32x4 w; w.x = pk2h(r[0], r[1]); w.y = pk2h(r[2], r[3]); w.z = pk2h(r[4], r[5]); w.w = pk2h(r[6], r[7]);
        *(u32x4*)(Y + (size_t)m * DM + 512 + jc * 8) = w;
    }
}
__device__ void phase_prep(const Params& P) {
    unsigned char* ws = P.ws;
    const half_t* Z = (const half_t*)(ws + WS_Z); half_t* AL = (half_t*)(ws + WS_AL); half_t* Yb = (half_t*)(ws + WS_Y);
    const float* mu = P.in[5];
    const int gtid = blockIdx.x * NTHREADS + threadIdx.x, gth = gridDim.x * NTHREADS;
    for (int i = gtid; i < MTOK * 32; i += gth) {
        const int m = i >> 5, j = i & 31, t = m & (SEQ - 1);
        const half_t* zrow = Z + (size_t)m * NIN;
        const int cz = 1536 + j * 8;
        const h8 zc = *(const h8*)(zrow + cz); h8 zp;
        if (t > 0) zp = *(const h8*)(zrow - NIN + cz); else zp = (h8){0, 0, 0, 0, 0, 0, 0, 0};
        const f32x4 m0 = *(const f32x4*)(mu + cz), m1 = *(const f32x4*)(mu + cz + 4); float r[8];
#pragma unroll
        for (int e = 0; e < 8; ++e) { const float zz = (float)zc[e], mm = e < 4 ? m0[e & 3] : m1[e & 3]; float v = zz + ((float)zp[e] - zz) * mm;
            if (j < 8) { const float tt = __builtin_amdgcn_exp2f(2.88539008f * v); v = 1.0f - 2.0f * __builtin_amdgcn_rcpf(1.0f + tt); }
            else if (j >= 16) v = sigm(v);
            r[e] = v; }
        u32x4 w; w.x = pk2h(r[0], r[1]); w.y = pk2h(r[2], r[3]); w.z = pk2h(r[4], r[5]); w.w = pk2h(r[6], r[7]);
        *(u32x4*)(AL + (size_t)m * 256 + j * 8) = w;
    }
    pool_group<2>(Z, Yb, P.in[17], 0, gtid, gth);
    pool_group<4>(Z, Yb, P.in[17], 1, gtid, gth);
    pool_group<8>(Z, Yb, P.in[17], 2, gtid, gth);
    pool_group<16>(Z, Yb, P.in[17], 3, gtid, gth);
}

constexpr int TC = 32;
constexpr int STEPF = 384;
constexpr int SC_BUF = 0, SC_SCAL = 2 * TC * STEPF * 4, SC_YB = SC_SCAL + 2 * TC * 4 * 4, SC_VR = SC_YB + 4 * 32 * 33 * 4, SC_BR = SC_VR + 4 * TC * 32 * 2, SC_CST = SC_BR + 4 * TC * 4, SC_END = SC_CST + 8 * 64 * 4;
static_assert(SC_END <= LDS_BYTES, "scan lds");

__device__ __forceinline__ float wave_sum_dpp(float v) {
    v = red16(v);
    v += __int_as_float(__builtin_amdgcn_update_dpp(0, __float_as_int(v), 0x142, 0xA, 0xF, false));
    v += __int_as_float(__builtin_amdgcn_update_dpp(0, __float_as_int(v), 0x143, 0xC, 0xF, false));
    return __int_as_float(__builtin_amdgcn_readlane(__float_as_int(v), 63));
}

struct ScanRaw { h8 zr, zk, zv, pr, pk, pv, lw, la; };
struct ScanStep { f32x4 kkA, kkB, wrA, wrB, wA, wB, k2A, k2B, bnA, bnB, sc; float vv; };

__device__ __forceinline__ void scan_load_raw(ScanRaw& R, const half_t* __restrict__ Z, const half_t* __restrict__ LO, size_t mb, int t, int hc8) {
    const half_t* zp = Z + (mb + t) * NIN + hc8; const half_t* lp = LO + (mb + t) * 1536 + hc8;
    R.zr = *(const h8*)(zp); R.zk = *(const h8*)(zp + 512); R.zv = *(const h8*)(zp + 1024); R.lw = *(const h8*)(lp); R.la = *(const h8*)(lp + 512);
    if (t > 0) { R.pr = *(const h8*)(zp - NIN); R.pk = *(const h8*)(zp - NIN + 512); R.pv = *(const h8*)(zp - NIN + 1024); }
    else { R.pr = (h8){0, 0, 0, 0, 0, 0, 0, 0}; R.pk = R.pr; R.pv = R.pr; }
}

#define SCAN_BAR() do { asm volatile("s_waitcnt lgkmcnt(0)" ::: "memory"); __builtin_amdgcn_s_barrier(); asm volatile("" ::: "memory"); } while (0)
__device__ void phase_scan(LAS unsigned char* lds, const Params& P) {
    unsigned char* ws = P.ws;
    const half_t* Z = (const half_t*)(ws + WS_Z); const half_t* LO = (const half_t*)(ws + WS_LO);
    unsigned long long* XS = (unsigned long long*)(ws + WS_XS); half_t* Y = (half_t*)(ws + WS_Y);
    const int tid = threadIdx.x, lane = tid & 63, wave = __builtin_amdgcn_readfirstlane(tid >> 6);
    LAS float* bufs = (LAS float*)(lds + SC_BUF); LAS float* scal = (LAS float*)(lds + SC_SCAL); LAS float* ybs = (LAS float*)(lds + SC_YB);
    LAS half_t* vring = (LAS half_t*)(lds + SC_VR); LAS float* bring = (LAS float*)(lds + SC_BR);
    for (int item = blockIdx.x; item < 256; item += gridDim.x) {
        const int half = item & 1, bh = item >> 1, h = bh & 7, b = bh >> 3;
        const size_t mb = (size_t)b * SEQ;
        LAS float* cst = (LAS float*)(lds + SC_CST);
        if (tid < 64) { const int hc = h * 64 + tid; cst[tid] = P.in[5][hc]; cst[64 + tid] = P.in[5][512 + hc]; cst[128 + tid] = P.in[5][1024 + hc]; cst[192 + tid] = P.in[6][hc];
            cst[256 + tid] = P.in[8][hc]; cst[320 + tid] = P.in[11][hc]; cst[384 + tid] = P.in[12][hc]; cst[448 + tid] = P.in[13][hc]; }
        __syncthreads();
        if (wave >= 4) {
            const int pw = wave - 4, s8 = lane >> 3, cg = lane & 7, hc8 = h * 64 + cg * 8, tt = pw * 8 + s8;
            const int ptid = tid - 256, ft = ptid >> 3, q = ptid & 7, oc = h * 64 + half * 32 + q * 4;
            const f32x4 lng = *(const f32x4*)(P.in[14] + oc), lnb = *(const f32x4*)(P.in[15] + oc);
            unsigned long long* xs_mine = XS + ((size_t)(bh * 2 + half)) * SEQ; const unsigned long long* xs_peer = XS + ((size_t)(bh * 2 + (half ^ 1))) * SEQ;
#define SCAN_Y4(fc) (f32x4){ybs[((fc) & 3) * (32 * 33) + (q * 4 + 0) * 33 + ft], ybs[((fc) & 3) * (32 * 33) + (q * 4 + 1) * 33 + ft], ybs[((fc) & 3) * (32 * 33) + (q * 4 + 2) * 33 + ft], ybs[((fc) & 3) * (32 * 33) + (q * 4 + 3) * 33 + ft]}
#define SCAN_PUBLISH(fc) do { const f32x4 y4 = SCAN_Y4(fc); float s1 = (y4[0] + y4[1]) + (y4[2] + y4[3]), s2 = (y4[0] * y4[0] + y4[1] * y4[1]) + (y4[2] * y4[2] + y4[3] * y4[3]); \
                s1 = red8(s1); s2 = red8(s2) + 1e-30f; \
                if (q == 0) __hip_atomic_store(xs_mine + (fc) * TC + ft, ((unsigned long long)__float_as_uint(s2) << 32) | __float_as_uint(s1), __ATOMIC_RELAXED, __HIP_MEMORY_SCOPE_AGENT); } while (0)
#define SCAN_FINAL_LOAD(fz, G4, PW) do { const int t_ = (fz) * TC + ft; G4 = *(const h4*)(LO + (mb + t_) * 1536 + 1024 + oc); PW = __hip_atomic_load(xs_peer + t_, __ATOMIC_RELAXED, __HIP_MEMORY_SCOPE_AGENT); } while (0)
#define SCAN_FINAL(fz, G4, PW) do { const int t_ = (fz) * TC + ft; const f32x4 y4 = SCAN_Y4(fz); \
                const h4 g4 = G4; unsigned long long pw_ = PW; \
                { unsigned sp_ = 0; while (pw_ == 0ull && ++sp_ < (1u << 22)) { __builtin_amdgcn_s_sleep(1); pw_ = __hip_atomic_load(xs_peer + t_, __ATOMIC_RELAXED, __HIP_MEMORY_SCOPE_AGENT); } } \
                float s1 = (y4[0] + y4[1]) + (y4[2] + y4[3]), s2 = (y4[0] * y4[0] + y4[1] * y4[1]) + (y4[2] * y4[2] + y4[3] * y4[3]); \
                s1 = red8(s1) + __uint_as_float((unsigned)pw_); s2 = red8(s2) + __uint_as_float((unsigned)(pw_ >> 32)); \
                const float mean = s1 * (1.0f / 64.0f), var = fmaxf(s2 * (1.0f / 64.0f) - mean * mean, 0.f), rstd = __builtin_amdgcn_rsqf(var + GN_EPS); \
                const h4 v4 = *(const LAS h4*)(vring + (((fz) & 3) * TC + ft) * 32 + q * 4); const float bon_ = bring[((fz) & 3) * TC + ft]; float o_[4]; \
                _Pragma("unroll") for (int j = 0; j < 4; ++j) o_[j] = ((y4[j] - mean) * rstd * lng[j] + lnb[j] + bon_ * (float)v4[j]) * (float)g4[j]; \
                u32x2 w2_; w2_.x = pk2h(o_[0], o_[1]); w2_.y = pk2h(o_[2], o_[3]); *(u32x2*)(Y + (mb + t_) * DM + oc) = w2_; } while (0)
            ScanRaw Ra, Rb;
            scan_load_raw(Ra, Z, LO, mb, tt, hc8);
#define SCAN_PROD_ITER(ch, CUR, NXT) do { \
                const int pc_ = (ch) + 1; \
                h4 fg4_ = (h4){0, 0, 0, 0}; unsigned long long fpw_ = 0ull; if ((ch) >= 2) SCAN_FINAL_LOAD((ch) - 2, fg4_, fpw_);     \
                  \
                float wv_[8]; half_t* wdst_ = nullptr; f32x4 pv_; const bool pdo_ = (pc_ < 64) && (ptid < 128); \
                if (pc_ < 64 && ptid < 84) { int it_ = item * 5376 + pc_ * 84 + ptid; const float* src_; half_t* db_; int N_, ldd_, kind_ = 0; \
                    if (it_ < 131072) { src_ = P.in[18]; db_ = (half_t*)(ws + WS_WOUT); N_ = DM; ldd_ = DM; } \
                    else if ((it_ -= 131072) < 360448) { src_ = P.in[21]; db_ = (half_t*)(ws + WS_WGU); N_ = DFF; ldd_ = DM; kind_ = 1; } \
                    else if ((it_ -= 360448) < 360448) { src_ = P.in[22]; db_ = (half_t*)(ws + WS_WGU); N_ = DFF; ldd_ = DM; kind_ = 2; } \
                    else if ((it_ -= 360448) < 360448) { src_ = P.in[23]; db_ = (half_t*)(ws + WS_WDN); N_ = DM; ldd_ = DFF; } \
                    else if ((it_ -= 360448) < 131072) { src_ = P.in[25]; db_ = (half_t*)(ws + WS_WPLG); N_ = DM; ldd_ = DM; } \
                    else { it_ -= 131072; src_ = P.in[24]; db_ = (half_t*)(ws + WS_WPLP); N_ = DM; ldd_ = DPLE; } \
                    const int kg_ = it_ / N_, n_ = it_ - kg_ * N_; \
                    const int row_ = kind_ ? ((n_ >> 7) * 256 + (n_ & 127) + (kind_ == 2 ? 128 : 0)) : n_; \
                    const float* sp_ = src_ + (size_t)(kg_ * 8) * N_ + n_; \
                    _Pragma("unroll") for (int e = 0; e < 8; ++e) wv_[e] = sp_[(size_t)e * N_]; \
                    wdst_ = db_ + (size_t)row_ * ldd_ + kg_ * 8; } \
                if (pdo_) pv_ = ((const f32x4*)P.in[1])[item * 8192 + pc_ * 128 + ptid]; \
                if (pc_ + 1 < 64) scan_load_raw(NXT, Z, LO, mb, (pc_ + 1) * TC + tt, hc8); \
                if (pc_ < 64) { \
                    LAS float* dst = bufs + (pc_ & 1) * (TC * STEPF) + tt * STEPF + cg * 8; LAS float* dsc = scal + (pc_ & 1) * (TC * 4); \
                    float kk[8], wr_[8], w_[8], k2[8], bn[8], vv_[8]; float ss = 0.f, brs = 0.f, krs = 0.f, bons = 0.f; \
                    float mu_r[8], mu_k[8], mu_v[8], w0c[8], a0c[8], kkc[8], kac[8], rkc[8]; \
                    _Pragma("unroll") for (int hf = 0; hf < 2; ++hf) { const LAS float* cp = cst + cg * 8 + hf * 4; \
                        const f32x4 c0 = *(const LAS f32x4*)(cp), c1 = *(const LAS f32x4*)(cp + 64), c2 = *(const LAS f32x4*)(cp + 128), c3 = *(const LAS f32x4*)(cp + 192), \
                                    c4 = *(const LAS f32x4*)(cp + 256), c5 = *(const LAS f32x4*)(cp + 320), c6 = *(const LAS f32x4*)(cp + 384), c7 = *(const LAS f32x4*)(cp + 448); \
                        _Pragma("unroll") for (int j = 0; j < 4; ++j) { mu_r[hf * 4 + j] = c0[j]; mu_k[hf * 4 + j] = c1[j]; mu_v[hf * 4 + j] = c2[j]; w0c[hf * 4 + j] = c3[j]; a0c[hf * 4 + j] = c4[j]; kkc[hf * 4 + j] = c5[j]; kac[hf * 4 + j] = c6[j]; rkc[hf * 4 + j] = c7[j]; } } \
                    _Pragma("unroll") for (int e = 0; e < 8; ++e) { \
                        const float r0 = (float)CUR.zr[e], k0 = (float)CUR.zk[e], v0 = (float)CUR.zv[e]; \
                        const float r = r0 + ((float)CUR.pr[e] - r0) * mu_r[e], k = k0 + ((float)CUR.pk[e] - k0) * mu_k[e]; vv_[e] = v0 + ((float)CUR.pv[e] - v0) * mu_v[e]; \
                        const float sg = sigm(w0c[e] + (float)CUR.lw[e]); \
                        const float w = __builtin_amdgcn_exp2f(-0.875057039f * sg); \
                        const float a = sigm(a0c[e] + (float)CUR.la[e]); \
                        const float kq = k * kkc[e]; ss += kq * kq; kk[e] = kq; \
                        k2[e] = k * (1.0f + (a - 1.0f) * kac[e]); \
                        bn[e] = -kq * a; brs += bn[e] * r; \
                        const float pr = k2[e] * r; krs += pr; bons += pr * rkc[e]; \
                        w_[e] = w; wr_[e] = w * r; } \
                    ss = red8(ss); brs = red8(brs); krs = red8(krs); bons = red8(bons); \
                    const float rn = __builtin_amdgcn_rsqf(fmaxf(ss, 1e-24f)); brs *= rn; \
                    _Pragma("unroll") for (int e = 0; e < 8; ++e) { kk[e] *= rn; bn[e] *= rn; } \
                    *(LAS f32x4*)(dst) = (f32x4){kk[0], kk[1], kk[2], kk[3]}; *(LAS f32x4*)(dst + 4) = (f32x4){kk[4], kk[5], kk[6], kk[7]}; \
                    *(LAS f32x4*)(dst + 64) = (f32x4){wr_[0], wr_[1], wr_[2], wr_[3]}; *(LAS f32x4*)(dst + 68) = (f32x4){wr_[4], wr_[5], wr_[6], wr_[7]}; \
                    *(LAS f32x4*)(dst + 128) = (f32x4){w_[0], w_[1], w_[2], w_[3]}; *(LAS f32x4*)(dst + 132) = (f32x4){w_[4], w_[5], w_[6], w_[7]}; \
                    *(LAS f32x4*)(dst + 192) = (f32x4){k2[0], k2[1], k2[2], k2[3]}; *(LAS f32x4*)(dst + 196) = (f32x4){k2[4], k2[5], k2[6], k2[7]}; \
                    *(LAS f32x4*)(dst + 256) = (f32x4){bn[0], bn[1], bn[2], bn[3]}; *(LAS f32x4*)(dst + 260) = (f32x4){bn[4], bn[5], bn[6], bn[7]}; \
                    *(LAS f32x4*)(dst + 320) = (f32x4){vv_[0], vv_[1], vv_[2], vv_[3]}; *(LAS f32x4*)(dst + 324) = (f32x4){vv_[4], vv_[5], vv_[6], vv_[7]}; \
                    if (cg == 0) { *(LAS f32x4*)(dsc + tt * 4) = (f32x4){brs, krs, bons, 0.f}; bring[(pc_ & 3) * TC + tt] = bons; } \
                    if ((cg >> 2) == half) { u32x4 vw_; vw_.x = pk2h(vv_[0], vv_[1]); vw_.y = pk2h(vv_[2], vv_[3]); vw_.z = pk2h(vv_[4], vv_[5]); vw_.w = pk2h(vv_[6], vv_[7]); \
                        *(LAS u32x4*)(vring + ((pc_ & 3) * TC + tt) * 32 + (cg & 3) * 8) = vw_; } \
                } \
                if ((ch) >= 1) SCAN_PUBLISH((ch) - 1); \
                if ((ch) >= 2) SCAN_FINAL((ch) - 2, fg4_, fpw_); \
                if (wdst_) { u32x4 ww_; ww_.x = pk2h(wv_[0], wv_[1]); ww_.y = pk2h(wv_[2], wv_[3]); ww_.z = pk2h(wv_[4], wv_[5]); ww_.w = pk2h(wv_[6], wv_[7]); *(u32x4*)wdst_ = ww_; } \
                if (pdo_) { u32x2 pw2_; pw2_.x = pk2h(pv_[0], pv_[1]); pw2_.y = pk2h(pv_[2], pv_[3]); ((u32x2*)(ws + WS_P16))[item * 8192 + pc_ * 128 + ptid] = pw2_; } \
                __syncthreads(); \
            } while (0)
            for (int ch = -1; ch < 63; ch += 2) { SCAN_PROD_ITER(ch, Ra, Rb); SCAN_PROD_ITER(ch + 1, Rb, Ra); }
            SCAN_PROD_ITER(63, Ra, Rb);
#undef SCAN_PROD_ITER
            { h4 ga_, gb_; unsigned long long pa_, pb_; SCAN_FINAL_LOAD(62, ga_, pa_); SCAN_FINAL_LOAD(63, gb_, pb_); SCAN_PUBLISH(63); SCAN_FINAL(62, ga_, pa_); SCAN_FINAL(63, gb_, pb_); }
#undef SCAN_Y4
#undef SCAN_PUBLISH
#undef SCAN_FINAL
#undef SCAN_FINAL_LOAD
            __syncthreads();
        } else {
            const int row = wave * 8 + (lane >> 3), kl = lane & 7;
            f32x2 S0 = {0.f, 0.f}, S1 = {0.f, 0.f}, S2 = {0.f, 0.f}, S3 = {0.f, 0.f};
            __syncthreads();
            for (int ch = 0; ch < 64; ++ch) {
                const LAS float* src = bufs + (ch & 1) * (TC * STEPF); const LAS float* ssc = scal + (ch & 1) * (TC * 4); LAS float* yb = ybs + (ch & 3) * (32 * 33) + row * 33 + kl; float ykeep = 0.f;
                const LAS float* sbk = src + kl * 8; const LAS float* sbv = src + 320 + half * 32 + row;
#define SCAN_LOAD(Q, tt) do { const LAS float* sb = sbk + (tt) * STEPF; \
                    Q.kkA = *(const LAS f32x4*)(sb); Q.kkB = *(const LAS f32x4*)(sb + 4); Q.wrA = *(const LAS f32x4*)(sb + 64); Q.wrB = *(const LAS f32x4*)(sb + 68); \
                    Q.wA = *(const LAS f32x4*)(sb + 128); Q.wB = *(const LAS f32x4*)(sb + 132); Q.k2A = *(const LAS f32x4*)(sb + 192); Q.k2B = *(const LAS f32x4*)(sb + 196); \
                    Q.bnA = *(const LAS f32x4*)(sb + 256); Q.bnB = *(const LAS f32x4*)(sb + 260); Q.vv = sbv[(tt) * STEPF]; Q.sc = *(const LAS f32x4*)(ssc + (tt) * 4); } while (0)
#define SCAN_COMPUTE(Q, tt) do { \
                    f32x2 pa2 = S0 * (f32x2){Q.kkA[0], Q.kkA[1]}; pa2 = S1 * (f32x2){Q.kkA[2], Q.kkA[3]} + pa2; pa2 = S2 * (f32x2){Q.kkB[0], Q.kkB[1]} + pa2; pa2 = S3 * (f32x2){Q.kkB[2], Q.kkB[3]} + pa2; \
                    f32x2 py2 = S0 * (f32x2){Q.wrA[0], Q.wrA[1]}; py2 = S1 * (f32x2){Q.wrA[2], Q.wrA[3]} + py2; py2 = S2 * (f32x2){Q.wrB[0], Q.wrB[1]} + py2; py2 = S3 * (f32x2){Q.wrB[2], Q.wrB[3]} + py2; \
                    float pa = pa2[0] + pa2[1], py = py2[0] + py2[1]; \
                    pa = red8(pa); py = red8(py); \
                    const f32x2 vv2 = {Q.vv, Q.vv}, pav = {pa, pa}; \
                    S0 = S0 * (f32x2){Q.wA[0], Q.wA[1]} + vv2 * (f32x2){Q.k2A[0], Q.k2A[1]}; S0 = pav * (f32x2){Q.bnA[0], Q.bnA[1]} + S0; \
                    S1 = S1 * (f32x2){Q.wA[2], Q.wA[3]} + vv2 * (f32x2){Q.k2A[2], Q.k2A[3]}; S1 = pav * (f32x2){Q.bnA[2], Q.bnA[3]} + S1; \
                    S2 = S2 * (f32x2){Q.wB[0], Q.wB[1]} + vv2 * (f32x2){Q.k2B[0], Q.k2B[1]}; S2 = pav * (f32x2){Q.bnB[0], Q.bnB[1]} + S2; \
                    S3 = S3 * (f32x2){Q.wB[2], Q.wB[3]} + vv2 * (f32x2){Q.k2B[2], Q.k2B[3]}; S3 = pav * (f32x2){Q.bnB[2], Q.bnB[3]} + S3; \
                    { const float y_ = py + pa * Q.sc[0] + Q.vv * Q.sc[1]; ykeep = (kl == ((tt) & 7)) ? y_ : ykeep;     \
                      if (((tt) & 7) == 7) yb[(tt) - 7] = ykeep; } \
                } while (0)
                ScanStep q0, q1, q2;
                SCAN_LOAD(q0, 0); SCAN_LOAD(q1, 1);
#pragma unroll
                for (int tt = 0; tt < TC; tt += 3) {
                    if (tt + 2 < TC) SCAN_LOAD(q2, tt + 2);
                    __builtin_amdgcn_sched_barrier(0);
                    SCAN_COMPUTE(q0, tt);
                    if (tt + 1 < TC) { if (tt + 3 < TC) SCAN_LOAD(q0, tt + 3); __builtin_amdgcn_sched_barrier(0); SCAN_COMPUTE(q1, tt + 1); }
                    if (tt + 2 < TC) { if (tt + 4 < TC) SCAN_LOAD(q1, tt + 4); __builtin_amdgcn_sched_barrier(0); SCAN_COMPUTE(q2, tt + 2); }
                }
#undef SCAN_LOAD
#undef SCAN_COMPUTE
                __syncthreads();
            }
            __syncthreads();
        }
    }
}

__device__ void phase_ln1(const Params& P) {
    half_t* H1 = (half_t*)(P.ws + WS_H1);
    const int lane = threadIdx.x & 63, wv = threadIdx.x >> 6;
    for (int row = blockIdx.x * 8 + wv; row < MTOK; row += gridDim.x * 8) ln_row_to_f16(P.out + (size_t)row * DM, P.in[19], P.in[20], H1 + (size_t)row * DM, lane);
}
__device__ void phase_ln2(const Params& P) {
    const int lane = threadIdx.x & 63, wv = threadIdx.x >> 6;
    const float* g = P.in[26]; const float* b = P.in[27];
    for (int row = blockIdx.x * 8 + wv; row < MTOK; row += gridDim.x * 8) {
        float* xrow = P.out + (size_t)row * DM;
        f32x4 v[4]; float s = 0.f;
#pragma unroll
        for (int j = 0; j < 4; ++j) { v[j] = *(const f32x4*)(xrow + j * 256 + lane * 4); s += (v[j][0] + v[j][1]) + (v[j][2] + v[j][3]); }
        const float mu = wave_sum(s) * (1.0f / 1024.0f); float q = 0.f;
#pragma unroll
        for (int j = 0; j < 4; ++j) { v[j] = v[j] - mu; q += (v[j][0] * v[j][0] + v[j][1] * v[j][1]) + (v[j][2] * v[j][2] + v[j][3] * v[j][3]); }
        const float rstd = __builtin_amdgcn_rsqf(wave_sum(q) * (1.0f / 1024.0f) + LN_EPS);
#pragma unroll
        for (int j = 0; j < 4; ++j) { const f32x4 gg = *(const f32x4*)(g + j * 256 + lane * 4), bb = *(const f32x4*)(b + j * 256 + lane * 4);
            *(f32x4*)(xrow + j * 256 + lane * 4) = v[j] * rstd * gg + bb; }
    }
}

__global__ void __launch_bounds__(NTHREADS) fwd_megakernel(Params P) {
    extern __shared__ __attribute__((aligned(16))) unsigned char lds_raw[];
    LAS unsigned char* lds = (LAS unsigned char*)lds_raw;
    cg::grid_group grid = cg::this_grid();
    if (P.ph_hi < 0) grid.sync();
    volatile LAS unsigned* xst = (volatile LAS unsigned*)(lds + LDS_BYTES);
    if (threadIdx.x < 2) xst[threadIdx.x] = 0u;
    __syncthreads();
    XcdBarrier xbar = xcd_barrier_post((unsigned*)P.ws, xst);
    unsigned char* ws = P.ws;
    const int lo = P.ph_lo, hi = P.ph_hi, G = gridDim.x, bx = blockIdx.x;
#define IN(k) (lo <= (k) && (k) < hi)
#define REP(k) for (int rep_ = 0; rep_ < (((PROBE_DUP >> (k)) & 1) ? 2 : 1); ++rep_)
#ifndef PROBE_SYNCS
#define PROBE_SYNCS 0
#endif
#define SEAM(k) do { if (IN(k) && IN((k) + 1)) { xcd_barrier(xbar); for (int s_ = 0; s_ < PROBE_SYNCS; ++s_) xcd_barrier(xbar); } } while (0)
    if (IN(0)) REP(0) { phase_prologue(lds, P); } SEAM(0);
    if (IN(1)) REP(1) {
        pg8::Gemm g{(const half_t*)(ws + WS_H0), (const half_t*)(ws + WS_WIN), MTOK, NIN, DM}; pg8::StaticOrder S; S.init(MTOK, NIN, G, bx);
        pg8::EpiH E{(half_t*)(ws + WS_Z), NIN, 0, nullptr};
        pg8::gemm_phase<pg8::EpiH>(lds, g, S, E);
    } SEAM(1);
    if (IN(2)) REP(2) { phase_prep(P); } SEAM(2);
    if (IN(3)) REP(3) {
        { pg8::Gemm g{(const half_t*)(ws + WS_AL), (const half_t*)(ws + WS_WLORA), MTOK, 1536, 256}; pg8::StaticOrder S; S.init(MTOK, 1536, G, bx);
            pg8::EpiH E{(half_t*)(ws + WS_LO), 1536, 0, nullptr};
            pg8::gemm_phase<pg8::EpiH>(lds, g, S, E); }
    } SEAM(3);
    if (IN(4)) REP(4) { phase_scan(lds, P); } SEAM(4);
    LAS unsigned char* tl = lds + LDS_TAB;
    if (IN(6)) REP(6) {
        pg8::Gemm g{(const half_t*)(ws + WS_Y), (const half_t*)(ws + WS_WOUT), MTOK, DM, DM}; pg8::StaticOrder S; S.init(MTOK, DM, G, bx);
        pg8::PanelStats st{(unsigned long long*)(ws + WS_XB1), (unsigned*)(ws + CTL_CNT1), LN_EPS};
        pg8::EpiLN<false> E{(const half_t*)(ws + WS_H0), nullptr, P.in[19], P.in[20], (half_t*)(ws + WS_H1), nullptr, st, tl};
        pg8::gemm_phase<pg8::EpiLN<false>>(lds, g, S, E);
    } SEAM(6);
    if (IN(7)) REP(7) {
        { pg8::Gemm g{(const half_t*)(ws + WS_H1), (const half_t*)(ws + WS_WGU), MTOK, 2 * DFF, DM}; pg8::StaticOrder S; S.init(MTOK, 2 * DFF, G, bx);
            pg8::EpiSwiGLU E{(half_t*)(ws + WS_ACT), DFF};
            pg8::gemm_phase<pg8::EpiSwiGLU>(lds, g, S, E); }
        { pg8::Gemm g{(const half_t*)(ws + WS_P16), (const half_t*)(ws + WS_WPLP), MTOK, DM, DPLE}; pg8::StaticOrder S; S.init(MTOK, DM, G, bx);
            pg8::EpiH E{(half_t*)(ws + WS_E2), DM, 0, nullptr};
            pg8::gemm_phase<pg8::EpiH>(lds, g, S, E); }
        { pg8::Gemm g{(const half_t*)(ws + WS_H1), (const half_t*)(ws + WS_WPLG), MTOK, DM, DM}; pg8::StaticOrder S; S.init(MTOK, DM, G, bx);
            pg8::EpiE E{(half_t*)(ws + WS_E2), DM};
            pg8::gemm_phase<pg8::EpiE>(lds, g, S, E); }
    } SEAM(7);
    if (IN(8)) {
        pg8::Gemm g{(const half_t*)(ws + WS_ACT), (const half_t*)(ws + WS_WDN), MTOK, DM, DFF}; pg8::StaticOrder S; S.init(MTOK, DM, G, bx);
        pg8::PanelStats st{(unsigned long long*)(ws + WS_XB2), (unsigned*)(ws + CTL_CNT2), LN_EPS};
        pg8::EpiLN<true> E{(const half_t*)(ws + WS_H1), (const half_t*)(ws + WS_E2), P.in[26], P.in[27], nullptr, P.out, st, tl};
        pg8::gemm_phase<pg8::EpiLN<true>>(lds, g, S, E);
    }
#undef IN
#undef SEAM
}

extern "C" void kernel_launch(void* const* d_in, const int* in_sizes, int n_in, void* d_out, int out_size, void* d_ws, size_t ws_size, hipStream_t stream) {
    static int grid_blocks = 0;
    if (grid_blocks == 0) {
        if (n_in != 28 || out_size != MTOK * DM || ws_size < WS_END) { fprintf(stderr, "kernel_launch: unexpected shapes (n_in %d, out %d, ws %zu, need %zu)\n", n_in, out_size, ws_size, (size_t)WS_END); grid_blocks = -1; return; }
        int dev = 0, cus = 0, per_cu = 0;
        (void)hipGetDevice(&dev);
        (void)hipDeviceGetAttribute(&cus, hipDeviceAttributeMultiprocessorCount, dev);
        if (hipFuncSetAttribute((const void*)fwd_megakernel, hipFuncAttributeMaxDynamicSharedMemorySize, LDS_TOTAL) != hipSuccess) { fprintf(stderr, "kernel_launch: hipFuncSetAttribute failed\n"); grid_blocks = -1; return; }
        if (hipOccupancyMaxActiveBlocksPerMultiprocessor(&per_cu, (const void*)fwd_megakernel, NTHREADS, LDS_TOTAL) != hipSuccess || per_cu < 1) { fprintf(stderr, "kernel_launch: occupancy query failed (%d)\n", per_cu); per_cu = 1; (void)hipGetLastError(); }
        grid_blocks = cus * per_cu;
    }
    if (grid_blocks < 0) return;
    Params p{};
    for (int i = 0; i < 28; ++i) p.in[i] = (const float*)d_in[i];
    p.out = (float*)d_out; p.ws = (unsigned char*)d_ws;
    static_assert(WS_XS == CTL_BYTES && WS_XS + XS_BYTES <= WS_WIN, "control words and exchange slots are one contiguous region");
    (void)hipMemsetAsync(d_ws, 0, CTL_BYTES, stream);
#if N_LAUNCH_MODE == 1
    p.ph_lo = 0; p.ph_hi = NPHASE;
    { void* args[] = {&p};
        hipError_t e = hipLaunchCooperativeKernel((const void*)fwd_megakernel, dim3(grid_blocks), dim3(NTHREADS), args, LDS_TOTAL, stream);
        if (e != hipSuccess) fprintf(stderr, "cooperative launch failed: %s (grid %d)\n", hipGetErrorString(e), grid_blocks); }
#else
    for (int ph = 0; ph < NPHASE; ++ph) {
        p.ph_lo = ph; p.ph_hi = ph + 1;
        void* args[] = {&p};
        hipError_t e = hipLaunchCooperativeKernel((const void*)fwd_megakernel, dim3(grid_blocks), dim3(NTHREADS), args, LDS_TOTAL, stream);
        if (e != hipSuccess) { fprintf(stderr, "launch %d failed: %s (grid %d)\n", ph, hipGetErrorString(e), grid_blocks); break; }
    }
#endif
}
```

```cpp
#include <hip/hip_runtime.h>
#include <hip/hip_cooperative_groups.h>
#include <cstdio>
namespace cg = cooperative_groups;

#ifndef N_LAUNCH_MODE
#define N_LAUNCH_MODE 1
#endif

#ifndef PROBE_DUP
#define PROBE_DUP 0
#endif
#define LAS __attribute__((address_space(3)))
typedef _Float16 half_t;
typedef _Float16 h8 __attribute__((ext_vector_type(8)));
typedef _Float16 h4 __attribute__((ext_vector_type(4)));
typedef _Float16 h2 __attribute__((ext_vector_type(2)));
typedef float f32x4 __attribute__((ext_vector_type(4)));
typedef float f32x2 __attribute__((ext_vector_type(2)));
typedef unsigned u32x4 __attribute__((ext_vector_type(4)));
typedef unsigned u32x2 __attribute__((ext_vector_type(2)));
typedef unsigned long long u64x2 __attribute__((ext_vector_type(2)));

constexpr int MTOK = 32768, SEQ = 2048, DM = 1024, NIN = 2304, RWW = 512, DFF = 2816, DPLE = 256, NH = 8;
constexpr float ALPHA = 1.189207115f;
constexpr float LN_EPS = 1e-5f, GN_EPS = 64e-5f;
constexpr int NTHREADS = 512;
constexpr int LDS_BYTES = 131072;
constexpr int LDS_TAB = LDS_BYTES + 64;
constexpr int LDS_TOTAL = LDS_TAB + 10240 + 64;
constexpr int NPHASE = 9;

constexpr size_t MiB = 1024 * 1024;
constexpr size_t WS_WIN = 5 * MiB;
constexpr size_t WS_WOUT = WS_WIN + (size_t)NIN * DM * 2;
constexpr size_t WS_WGU = WS_WOUT + (size_t)DM * DM * 2;
constexpr size_t WS_WDN = WS_WGU + (size_t)2 * DFF * DM * 2;
constexpr size_t WS_WPLG = WS_WDN + (size_t)DM * DFF * 2;
constexpr size_t WS_WPLP = WS_WPLG + (size_t)DM * DM * 2;
constexpr size_t WS_WLORA = WS_WPLP + (size_t)DM * DPLE * 2;
constexpr size_t WS_WPOOL = WS_WLORA + (size_t)1536 * 256 * 2;
constexpr size_t WS_WEND = WS_WPOOL + (size_t)512 * 512 * 2;
static_assert(WS_WEND <= 32 * MiB, "weights region");
constexpr size_t WS_BON = 30 * MiB;
constexpr size_t WS_H0 = 32 * MiB;
constexpr size_t WS_Z = 96 * MiB;
constexpr size_t WS_LO = 240 * MiB;
constexpr size_t WS_AL = 336 * MiB;
constexpr size_t WS_DP = 352 * MiB;
constexpr size_t WS_P16 = 384 * MiB;
constexpr size_t WS_Y = 400 * MiB;
constexpr size_t WS_XB1 = 464 * MiB;
constexpr size_t WS_XB2 = 465 * MiB;
constexpr size_t WS_XS = 128 * 1024;
constexpr size_t XS_BYTES = (size_t)128 * 2 * SEQ * 8;
constexpr size_t WS_END = 498 * MiB;
constexpr size_t CTL_CNT1 = 65536, CTL_CNT2 = 65536 + 32768, CTL_BYTES = 131072;
constexpr size_t WS_H1 = WS_Z;
constexpr size_t WS_ACT = WS_Z + 64 * MiB;
constexpr size_t WS_E2 = WS_Y;
static_assert(WS_ACT + (size_t)MTOK * DFF * 2 <= WS_AL, "ACT alias");

struct Params {
    const float* in[28];
    float* out;
    unsigned char* ws;
    int ph_lo, ph_hi;
};

__device__ __forceinline__ unsigned pk2h(float a, float b) { h2 v; v.x = (_Float16)a; v.y = (_Float16)b; return __builtin_bit_cast(unsigned, v); }
__device__ __forceinline__ float sigm(float x) { return __builtin_amdgcn_rcpf(1.0f + __builtin_amdgcn_exp2f(-1.44269504f * x)); }
template <int CTRL> __device__ __forceinline__ float dpp_get(float v) { return __int_as_float(__builtin_amdgcn_update_dpp(0, __float_as_int(v), CTRL, 0xF, 0xF, false)); }
__device__ __forceinline__ float red8(float v) { v += dpp_get<0xB1>(v); v += dpp_get<0x4E>(v); v += dpp_get<0x141>(v); return v; }
__device__ __forceinline__ float red16(float v) { v = red8(v); v += dpp_get<0x140>(v); return v; }
__device__ __forceinline__ float wave_sum(float v) { v = red16(v); v += __shfl_xor(v, 16); v += __shfl_xor(v, 32); return v; }


#define XB_TMO      128
#define XB_XCNT(j)  (256  + 64 * (j))
#define XB_XSUB(j)  (1280 + 64 * (j))
#define XB_XGEN(j)  (2304 + 64 * (j))
#define XB_TOP      3328
#define XB_TOPGEN   3392
#define XCD_BAR_WORDS 3456
#define XB_SPIN_CAP (1u << 20)
__device__ __forceinline__ unsigned xb_ld(unsigned* p)              { return __hip_atomic_load(p, __ATOMIC_RELAXED, __HIP_MEMORY_SCOPE_AGENT); }
__device__ __forceinline__ unsigned xb_add(unsigned* p, unsigned v) { return __hip_atomic_fetch_add(p, v, __ATOMIC_RELAXED, __HIP_MEMORY_SCOPE_AGENT); }
__device__ __forceinline__ unsigned xb_xcc_id() { return (unsigned)__builtin_amdgcn_s_getreg((3 << 11) | 20) & 0xFu; }
#define XB_SPIN(cond, bar) do { unsigned _sp = 0; while (cond) { __builtin_amdgcn_s_sleep(1); \
    if ((++_sp & 255u) == 0u) { if (xb_ld(&(bar)[XB_TMO])) break; if (_sp > XB_SPIN_CAP) { atomicAdd(&(bar)[XB_TMO], 1u); break; } } } } while (0)
struct XcdBarrier { unsigned* bar; unsigned x; volatile LAS unsigned* st; };
__device__ __forceinline__ XcdBarrier xcd_barrier_post(unsigned* bar, volatile LAS unsigned* st) {
    XcdBarrier b; b.bar = bar; b.x = xb_xcc_id(); b.st = st;
    if (threadIdx.x == 0) (void)xb_add(&bar[XB_XCNT(b.x)], 1u);
    return b;
}
__device__ __forceinline__ void xcd_barrier_complete(unsigned* bar, unsigned x, unsigned& nloc, unsigned& nx) {
    const unsigned G = gridDim.x * gridDim.y * gridDim.z;
    unsigned sum, cnt, mine, sp = 0u;
    for (;;) {
        sum = 0u; cnt = 0u; mine = 0u;
#pragma unroll
        for (unsigned j = 0; j < 16; ++j) { const unsigned c = xb_ld(&bar[XB_XCNT(j)]); sum += c; cnt += (c > 0u) ? 1u : 0u; mine = (j == x) ? c : mine; }
        if (sum == G) break;
        __builtin_amdgcn_s_sleep(1);
        if ((++sp & 255u) == 0u) { if (xb_ld(&bar[XB_TMO])) break; if (sp > XB_SPIN_CAP) { atomicAdd(&bar[XB_TMO], 1u); break; } }
    }
    nloc = mine > 0u ? mine : 1u; nx = cnt > 0u ? cnt : 1u;
}
__device__ __forceinline__ void xcd_barrier(const XcdBarrier& b) {
    asm volatile("s_waitcnt vmcnt(0)" ::: "memory");
    __syncthreads();
    if (threadIdx.x == 0) {
        unsigned* bar = b.bar;
        __builtin_amdgcn_s_waitcnt(0);
        unsigned nloc = b.st[0], nx = b.st[1];
        if (nloc == 0u) { xcd_barrier_complete(bar, b.x, nloc, nx); b.st[0] = nloc; b.st[1] = nx; }
        const unsigned old = xb_add(&bar[XB_XSUB(b.x)], 1u);
        const unsigned gen = old / nloc;
        if (old + 1u == (gen + 1u) * nloc) {
            __builtin_amdgcn_fence(__ATOMIC_RELEASE, "agent");
            asm volatile("s_waitcnt vmcnt(0)" ::: "memory");
            const unsigned og = xb_add(&bar[XB_TOP], 1u);
            const unsigned tg = og / nx;
            if (og + 1u == (tg + 1u) * nx) xb_add(&bar[XB_TOPGEN], 1u);
            else XB_SPIN(xb_ld(&bar[XB_TOPGEN]) == tg, bar);
            __builtin_amdgcn_fence(__ATOMIC_ACQUIRE, "agent");
            xb_add(&bar[XB_XGEN(b.x)], 1u);
            asm volatile("s_waitcnt vmcnt(0)" ::: "memory");
        } else {
            XB_SPIN(xb_ld(&bar[XB_XGEN(b.x)]) == gen, bar);
            __builtin_amdgcn_fence(__ATOMIC_ACQUIRE, "agent");
            asm volatile("s_waitcnt vmcnt(0)" ::: "memory");
        }
    }
    __syncthreads();
}

namespace pg8 {
constexpr int BM = 256, BK = 64, HALF = 128, HTB = HALF * BK * 2, STAGE_BYTES = 8 * HTB, NXCD = 8, WGM = 8;
__device__ __forceinline__ int lds_byte(int r, int c) { const int st = (r >> 4) * 2 + (c >> 5), rr = r & 15, cc = c & 31, ob = rr * 64 + cc * 2; return st * 1024 + (ob ^ (((ob >> 9) & 1) << 5)); }
__device__ __forceinline__ void stage_rc(int b, int& R, int& C) { const int st = b / 1024, sb = b % 1024, swz = sb ^ (((sb >> 9) & 1) << 5); R = (st >> 1) * 16 + swz / 64; C = (st & 1) * 32 + (swz % 64) / 2; }
__device__ __forceinline__ int perm32(int rho) { const int n = rho >> 4, i = rho & 15; return 8 * (i >> 2) + 4 * n + (i & 3); }

struct Unit { int pm, pn; };
struct Gemm { const half_t* A; const half_t* Bt; int M, N, K; };
struct StaticOrder {
    int nM, nN, nwg, G, c;
    __device__ void init(int M, int N, int G_, int c_) { nM = M / BM; nN = N / BM; nwg = nM * nN; G = G_; c = c_; }
    __device__ bool next(int i, Unit& u) const {
        const long L = (long)i * G + c; if (L >= nwg) return false;
        int wgid = (int)L; { const int q = nwg / NXCD, r = nwg % NXCD, xcd = wgid % NXCD, off = wgid / NXCD; wgid = (xcd < r ? xcd * (q + 1) : r * (q + 1) + (xcd - r) * q) + off; }
        const int nig = WGM * nN, gid = wgid / nig, fm = gid * WGM, gsz = (nM - fm) < WGM ? (nM - fm) : WGM;
        u.pm = fm + ((wgid % nig) % gsz); u.pn = (wgid % nig) / gsz; return true;
    }
};


struct EpiH {
    static constexpr bool PERM = true, SYNC = false;
    half_t* O; int ldc; int coff; const float* scale;
    __device__ __forceinline__ void operator()(const f32x4 (&acc)[2][2][4][2], const Unit& u, int wr, int wc, int fr, int fq) const {
        const int row0 = u.pm * BM + wr * 64 + fr, col0 = u.pn * BM + wc * 32 + 8 * fq;
        f32x4 sv[2][2];
#pragma unroll
        for (int bj = 0; bj < 2; ++bj)
#pragma unroll
            for (int n = 0; n < 2; ++n) sv[bj][n] = scale ? *(const f32x4*)(scale + col0 + bj * HALF + 4 * n) : (f32x4){1.f, 1.f, 1.f, 1.f};
#pragma unroll
        for (int ai = 0; ai < 2; ++ai)
#pragma unroll
            for (int m = 0; m < 4; ++m) { half_t* rowp = O + (size_t)(row0 + ai * HALF + m * 16) * ldc + coff + col0;
#pragma unroll
                for (int bj = 0; bj < 2; ++bj) { const f32x4 v0 = acc[ai][bj][m][0] * sv[bj][0], v1 = acc[ai][bj][m][1] * sv[bj][1];
                    u32x4 w; w.x = pk2h(v0[0], v0[1]); w.y = pk2h(v0[2], v0[3]); w.z = pk2h(v1[0], v1[1]); w.w = pk2h(v1[2], v1[3]);
                    *(u32x4*)(rowp + bj * HALF) = w; } }
    }
};
struct EpiSwiGLU {
    static constexpr bool PERM = true, SYNC = false;
    half_t* O; int ldc;
    __device__ __forceinline__ void operator()(const f32x4 (&acc)[2][2][4][2], const Unit& u, int wr, int wc, int fr, int fq) const {
        const int row0 = u.pm * BM + wr * 64 + fr, col0 = u.pn * HALF + wc * 32 + 8 * fq;
#pragma unroll
        for (int ai = 0; ai < 2; ++ai)
#pragma unroll
            for (int m = 0; m < 4; ++m) { half_t* rowp = O + (size_t)(row0 + ai * HALF + m * 16) * ldc + col0;
                float r[8];
#pragma unroll
                for (int n = 0; n < 2; ++n)
#pragma unroll
                    for (int j = 0; j < 4; ++j) { const float g = acc[ai][0][m][n][j], up = acc[ai][1][m][n][j]; r[n * 4 + j] = g * sigm(g) * up; }
                u32x4 w; w.x = pk2h(r[0], r[1]); w.y = pk2h(r[2], r[3]); w.z = pk2h(r[4], r[5]); w.w = pk2h(r[6], r[7]);
                *(u32x4*)rowp = w; }
    }
};
struct EpiE {
    static constexpr bool PERM = true, SYNC = false;
    half_t* E; int ldc;
    __device__ __forceinline__ void operator()(const f32x4 (&acc)[2][2][4][2], const Unit& u, int wr, int wc, int fr, int fq) const {
        const int row0 = u.pm * BM + wr * 64 + fr, col0 = u.pn * BM + wc * 32 + 8 * fq;
#pragma unroll
        for (int ai = 0; ai < 2; ++ai)
#pragma unroll
            for (int m = 0; m < 4; ++m) { half_t* rowp = E + (size_t)(row0 + ai * HALF + m * 16) * ldc + col0;
#pragma unroll
                for (int bj = 0; bj < 2; ++bj) {
                    const unsigned long long* ep = (const unsigned long long*)(rowp + bj * HALF);
                    u64x2 e01; e01.x = __hip_atomic_load(ep, __ATOMIC_RELAXED, __HIP_MEMORY_SCOPE_AGENT); e01.y = __hip_atomic_load(ep + 1, __ATOMIC_RELAXED, __HIP_MEMORY_SCOPE_AGENT);
                    const h8 e = __builtin_bit_cast(h8, e01); float r[8];
#pragma unroll
                    for (int n = 0; n < 2; ++n)
#pragma unroll
                        for (int j = 0; j < 4; ++j) r[n * 4 + j] = sigm(acc[ai][bj][m][n][j]) * (float)e[n * 4 + j];
                    u32x4 w; w.x = pk2h(r[0], r[1]); w.y = pk2h(r[2], r[3]); w.z = pk2h(r[4], r[5]); w.w = pk2h(r[6], r[7]);
                    *(u32x4*)(rowp + bj * HALF) = w; } }
    }
};
template <bool HAS2> struct EpiRes {
    static constexpr bool PERM = false, SYNC = false;
    float* C; const half_t* R1; const half_t* R2; int ldc;
    __device__ __forceinline__ void operator()(const f32x4 (&acc)[2][2][4][2], const Unit& u, int wr, int wc, int fr, int fq) const {
        const int row0 = u.pm * BM + wr * 64 + fr, col0 = u.pn * BM + wc * 32 + 4 * fq;
#pragma unroll
        for (int ai = 0; ai < 2; ++ai)
#pragma unroll
            for (int m = 0; m < 4; ++m) { const size_t off = (size_t)(row0 + ai * HALF + m * 16) * ldc + col0;
#pragma unroll
                for (int bj = 0; bj < 2; ++bj)
#pragma unroll
                    for (int n = 0; n < 2; ++n) { const size_t o = off + bj * HALF + n * 16; const h4 a = *(const h4*)(R1 + o);
                        f32x4 v = acc[ai][bj][m][n]; v[0] += ALPHA * (float)a[0]; v[1] += ALPHA * (float)a[1]; v[2] += ALPHA * (float)a[2]; v[3] += ALPHA * (float)a[3];
                        if (HAS2) { const h4 e = *(const h4*)(R2 + o); v[0] += (float)e[0]; v[1] += (float)e[1]; v[2] += (float)e[2]; v[3] += (float)e[3]; }
                        *(f32x4*)(C + o) = v; } }
    }
};


struct PanelStats {
    unsigned long long* xbuf; unsigned* cnt; float eps;
    __device__ __forceinline__ void run(const f32x4 (&v)[2][2][4][2], const Unit& u, int wr, int wc, int fr, int fq, LAS unsigned char* tl, int wid, int lane) const {
        LAS f32x2* Pt = (LAS f32x2*)tl; LAS f32x2* St = (LAS f32x2*)(tl + 8192);
#pragma unroll
        for (int ai = 0; ai < 2; ++ai)
#pragma unroll
            for (int m = 0; m < 4; ++m) {
                float s = 0.f;
#pragma unroll
                for (int bj = 0; bj < 2; ++bj)
#pragma unroll
                    for (int n = 0; n < 2; ++n) { const f32x4 x = v[ai][bj][m][n]; s += (x[0] + x[1]) + (x[2] + x[3]); }
                s += __shfl_xor(s, 16); s += __shfl_xor(s, 32);
                const float mw = s * (1.0f / 64.0f); float q = 0.f;
#pragma unroll
                for (int bj = 0; bj < 2; ++bj)
#pragma unroll
                    for (int n = 0; n < 2; ++n) { const f32x4 d = v[ai][bj][m][n] - mw; q += (d[0] * d[0] + d[1] * d[1]) + (d[2] * d[2] + d[3] * d[3]); }
                q += __shfl_xor(q, 16); q += __shfl_xor(q, 32);
                if (fq == 0) Pt[(ai * HALF + wr * 64 + m * 16 + fr) * 4 + wc] = (f32x2){mw, q};
            }
        asm volatile("s_waitcnt lgkmcnt(0)" ::: "memory"); __builtin_amdgcn_s_barrier(); asm volatile("" ::: "memory");
        const int row = wid * 32 + (lane & 31);
        if (lane < 32) {
            const f32x2 a = Pt[row * 4 + 0], b = Pt[row * 4 + 1], c = Pt[row * 4 + 2], d = Pt[row * 4 + 3];
            const float mt = (a.x + b.x + c.x + d.x) * 0.25f;
            const float da = a.x - mt, db = b.x - mt, dc = c.x - mt, dd = d.x - mt;
            const float m2 = (a.y + b.y) + (c.y + d.y) + 64.0f * ((da * da + db * db) + (dc * dc + dd * dd));
            unsigned long long* slot = xbuf + ((size_t)(u.pm * BM + row) * 4 + u.pn);
            __hip_atomic_store(slot, ((unsigned long long)__float_as_uint(m2) << 32) | __float_as_uint(mt), __ATOMIC_RELAXED, __HIP_MEMORY_SCOPE_AGENT);
        }
        asm volatile("s_waitcnt vmcnt(0)" ::: "memory");
        if (lane == 0) __hip_atomic_fetch_add(cnt + 64 * u.pm, 1u, __ATOMIC_RELAXED, __HIP_MEMORY_SCOPE_AGENT);
        if (wid == 0) {
            unsigned sp = 0;
            while ((unsigned)__builtin_amdgcn_readfirstlane(__hip_atomic_load(cnt + 64 * u.pm, __ATOMIC_RELAXED, __HIP_MEMORY_SCOPE_AGENT)) < 32u) { __builtin_amdgcn_s_sleep(2); if (++sp > (1u << 22)) break; }
            __builtin_amdgcn_fence(__ATOMIC_ACQUIRE, "agent");
        }
        asm volatile("s_waitcnt vmcnt(0) lgkmcnt(0)" ::: "memory"); __builtin_amdgcn_s_barrier(); asm volatile("" ::: "memory");
        if (lane < 32) {
            const unsigned long long* slot = xbuf + (size_t)(u.pm * BM + row) * 4; float mt[4], m2[4]; float ms = 0.f;
#pragma unroll
            for (int t = 0; t < 4; ++t) { const unsigned long long w = __hip_atomic_load(slot + t, __ATOMIC_RELAXED, __HIP_MEMORY_SCOPE_AGENT); mt[t] = __uint_as_float((unsigned)w); m2[t] = __uint_as_float((unsigned)(w >> 32)); ms += mt[t]; }
            const float mean = ms * 0.25f; float q = 0.f;
#pragma unroll
            for (int t = 0; t < 4; ++t) { const float dm = mt[t] - mean; q += m2[t] + 256.0f * dm * dm; }
            St[row] = (f32x2){mean, __builtin_amdgcn_rsqf(q * (1.0f / 1024.0f) + eps)};
        }
        asm volatile("s_waitcnt lgkmcnt(0)" ::: "memory"); __builtin_amdgcn_s_barrier(); asm volatile("" ::: "memory");
    }
};
template <bool FINAL> struct EpiLN {
    static constexpr bool PERM = false, SYNC = true;
    const half_t* R1; const half_t* R2; const float* g; const float* b; half_t* H; float* C; PanelStats st; LAS unsigned char* tl;
    __device__ __forceinline__ void operator()(f32x4 (&acc)[2][2][4][2], const Unit& u, int wr, int wc, int fr, int fq) const {
        const int lane = threadIdx.x & 63, wid = __builtin_amdgcn_readfirstlane(threadIdx.x >> 6);
        const int row0 = u.pm * BM + wr * 64 + fr, col0 = u.pn * BM + wc * 32 + 4 * fq;
#pragma unroll
        for (int ai = 0; ai < 2; ++ai)
#pragma unroll
            for (int m = 0; m < 4; ++m) { const size_t off = (size_t)(row0 + ai * HALF + m * 16) * DM + col0;
#pragma unroll
                for (int bj = 0; bj < 2; ++bj)
#pragma unroll
                    for (int n = 0; n < 2; ++n) { const size_t o = off + bj * HALF + n * 16; const h4 a = *(const h4*)(R1 + o);
                        f32x4 v = acc[ai][bj][m][n]; v[0] += ALPHA * (float)a[0]; v[1] += ALPHA * (float)a[1]; v[2] += ALPHA * (float)a[2]; v[3] += ALPHA * (float)a[3];
                        if (FINAL) { const h4 e = *(const h4*)(R2 + o); v[0] += (float)e[0]; v[1] += (float)e[1]; v[2] += (float)e[2]; v[3] += (float)e[3]; }
                        acc[ai][bj][m][n] = v; }
                asm volatile("" : "+v"(acc[ai][0][m][0]), "+v"(acc[ai][0][m][1]), "+v"(acc[ai][1][m][0]), "+v"(acc[ai][1][m][1]));
                asm volatile("" ::: "memory"); }
        f32x4 gvv[2][2], bvv[2][2];
#pragma unroll
        for (int bj = 0; bj < 2; ++bj)
#pragma unroll
            for (int n = 0; n < 2; ++n) { gvv[bj][n] = *(const f32x4*)(g + col0 + bj * HALF + n * 16); bvv[bj][n] = *(const f32x4*)(b + col0 + bj * HALF + n * 16); }
        st.run(acc, u, wr, wc, fr, fq, tl, wid, lane);
        const LAS f32x2* St = (const LAS f32x2*)(tl + 8192);
#pragma unroll
        for (int ai = 0; ai < 2; ++ai)
#pragma unroll
            for (int m = 0; m < 4; ++m) { const int r = ai * HALF + wr * 64 + m * 16 + fr; const f32x2 sr = St[r]; const size_t off = (size_t)(u.pm * BM + r) * DM + col0;
#pragma unroll
                for (int bj = 0; bj < 2; ++bj)
#pragma unroll
                    for (int n = 0; n < 2; ++n) {
                        const f32x4 o = (acc[ai][bj][m][n] - sr.x) * sr.y * gvv[bj][n] + bvv[bj][n]; const size_t oo = off + bj * HALF + n * 16;
                        if (FINAL) *(f32x4*)(C + oo) = o;
                        else { u32x2 w; w.x = pk2h(o[0], o[1]); w.y = pk2h(o[2], o[3]); *(u32x2*)(H + oo) = w; } }
                asm volatile("" ::: "memory"); }
        asm volatile("s_waitcnt lgkmcnt(0)" ::: "memory"); __builtin_amdgcn_s_barrier(); asm volatile("" ::: "memory");
    }
};

template <class Epi>
__device__ __forceinline__ void gemm_phase(LAS unsigned char* lds, const Gemm g, const StaticOrder& S, const Epi& E) {
    const int tid = threadIdx.x, wid = __builtin_amdgcn_readfirstlane(tid >> 6), lane = tid & 63, wr = wid >> 2, wc = wid & 3, fr = lane & 15, fq = lane >> 4;
    const int K = g.K, nt = K / BK;
    unsigned voffA[2], voffB[2];
#pragma unroll
    for (int i = 0; i < 2; ++i) { int R, C; stage_rc(tid * 16 + i * 8192, R, C); const int Rb = Epi::PERM ? ((R & ~31) + perm32(R & 31)) : R;
        voffA[i] = (unsigned)(R * K + C) * 2u; voffB[i] = (unsigned)(Rb * K + C) * 2u; }
    const size_t kstep = (size_t)(BK * 2);
    const size_t hstep = (size_t)HALF * K * 2;
    const size_t tstep = 2 * hstep;
    const unsigned ldsw = (unsigned)wid * 1024u;
    const int aoff = lds_byte(wr * 64 + fr, fq * 8), boff = lds_byte(wc * 32 + fr, fq * 8);
#define PG8_SA(b, h) (((b) * 2 + (h)) * HTB)
#define PG8_SB(b, h) ((4 + (b) * 2 + (h)) * HTB)
#define PG8_STAGE(bufoff, gbase, voff) do { _Pragma("unroll") for (int _i = 0; _i < 2; ++_i) \
        __builtin_amdgcn_global_load_lds((const unsigned*)((const char*)(gbase) + (voff)[_i]), (LAS unsigned*)(lds + (bufoff) + ldsw + _i * 8192), 16, 0, 0); } while (0)
#define PG8_LDA(dst, b, h) do { _Pragma("unroll") for (int m = 0; m < 4; ++m) _Pragma("unroll") for (int k = 0; k < 2; ++k) dst[m][k] = *(const LAS h8*)(lds + PG8_SA(b, h) + aoff + m * 2048 + k * 1024); } while (0)
#define PG8_LDB(dst, b, h) do { _Pragma("unroll") for (int n = 0; n < 2; ++n) _Pragma("unroll") for (int k = 0; k < 2; ++k) dst[n][k] = *(const LAS h8*)(lds + PG8_SB(b, h) + boff + n * 2048 + k * 1024); } while (0)
#define PG8_MMA(ai, bj, At, Bt) do { __builtin_amdgcn_s_setprio(1); _Pragma("unroll") for (int m = 0; m < 4; ++m) _Pragma("unroll") for (int n = 0; n < 2; ++n) _Pragma("unroll") for (int k = 0; k < 2; ++k) \
        acc[ai][bj][m][n] = __builtin_amdgcn_mfma_f32_16x16x32_f16(Bt[n][k], At[m][k], acc[ai][bj][m][n], 0, 0, 0); __builtin_amdgcn_s_setprio(0); } while (0)
#define PG8_WAIT_V(n) asm volatile("s_waitcnt vmcnt(" #n ")" ::: "memory")
#define PG8_WAIT_L(n) asm volatile("s_waitcnt lgkmcnt(" #n ")" ::: "memory")
#define PG8_BAR __builtin_amdgcn_s_barrier()
#define PG8_SCHED __builtin_amdgcn_sched_barrier(0)
    Unit cur, nxt; int ui = 0;
    if (!S.next(0, cur)) return;
    f32x4 acc[2][2][4][2];
#pragma unroll
    for (int a = 0; a < 2; ++a)
#pragma unroll
        for (int b = 0; b < 2; ++b)
#pragma unroll
            for (int m = 0; m < 4; ++m)
#pragma unroll
                for (int n = 0; n < 2; ++n) acc[a][b][m][n] = (f32x4){0.f, 0.f, 0.f, 0.f};
    h8 At[4][2], B0[2][2], B1[2][2];
    const char* cA = (const char*)g.A + (size_t)cur.pm * tstep; const char* cB = (const char*)g.Bt + (size_t)cur.pn * tstep;
    PG8_STAGE(PG8_SB(0, 0), cB, voffB); PG8_STAGE(PG8_SB(0, 1), cB + hstep, voffB); PG8_STAGE(PG8_SA(0, 0), cA, voffA); PG8_STAGE(PG8_SA(0, 1), cA + hstep, voffA);
    if (wr == 1) PG8_BAR;
    PG8_WAIT_V(2); PG8_BAR;
    PG8_STAGE(PG8_SB(1, 0), cB + kstep, voffB); PG8_STAGE(PG8_SA(1, 0), cA + kstep, voffA); PG8_STAGE(PG8_SB(1, 1), cB + hstep + kstep, voffB);
    PG8_WAIT_V(6); PG8_BAR;
    for (;;) {
        const bool has_next = S.next(ui + 1, nxt);
        const char* nA = has_next ? (const char*)g.A + (size_t)nxt.pm * tstep : cA; const char* nB = has_next ? (const char*)g.Bt + (size_t)nxt.pn * tstep : cB;
        for (int t = 0; t < nt; t += 2) {
            const bool last = (t == nt - 2);
            const char* a1 = cA + (size_t)(t + 1) * kstep;
            const char* a2 = last ? nA : cA + (size_t)(t + 2) * kstep; const char* b2 = last ? nB : cB + (size_t)(t + 2) * kstep;
            const char* a3 = a2 + kstep; const char* b3 = b2 + kstep;
            PG8_LDB(B0, 0, 0); PG8_LDB(B1, 0, 1); PG8_SCHED; PG8_LDA(At, 0, 0); PG8_STAGE(PG8_SA(1, 1), a1 + hstep, voffA);
            PG8_WAIT_V(8); PG8_WAIT_L(0); PG8_BAR; PG8_MMA(0, 0, At, B0); PG8_MMA(0, 1, At, B1); PG8_BAR; PG8_SCHED;
            PG8_LDA(At, 0, 1); PG8_STAGE(PG8_SB(0, 0), b2, voffB); PG8_STAGE(PG8_SB(0, 1), b2 + hstep, voffB); PG8_STAGE(PG8_SA(0, 0), a2, voffA);
            PG8_WAIT_V(8); PG8_WAIT_L(0); PG8_BAR; PG8_MMA(1, 0, At, B0); PG8_MMA(1, 1, At, B1); PG8_BAR; PG8_SCHED;
            PG8_LDB(B0, 1, 0); PG8_LDB(B1, 1, 1); PG8_SCHED; PG8_LDA(At, 1, 0); PG8_STAGE(PG8_SA(0, 1), a2 + hstep, voffA);
            PG8_WAIT_V(8); PG8_WAIT_L(0); PG8_BAR; PG8_MMA(0, 0, At, B0); PG8_MMA(0, 1, At, B1); PG8_BAR; PG8_SCHED;
            PG8_LDA(At, 1, 1); PG8_STAGE(PG8_SB(1, 0), b3, voffB); PG8_STAGE(PG8_SB(1, 1), b3 + hstep, voffB); PG8_STAGE(PG8_SA(1, 0), a3, voffA);
            PG8_WAIT_V(8); PG8_WAIT_L(0); PG8_BAR; PG8_MMA(1, 0, At, B0); PG8_MMA(1, 1, At, B1); PG8_BAR; PG8_SCHED;
        }
        if (wr == 0) PG8_BAR;
        E(acc, cur, wr, wc, fr, fq);
        if (wr == 1) PG8_BAR;
        if (!has_next) break;
#pragma unroll
        for (int a = 0; a < 2; ++a)
#pragma unroll
            for (int b = 0; b < 2; ++b)
#pragma unroll
                for (int m = 0; m < 4; ++m)
#pragma unroll
                    for (int n = 0; n < 2; ++n) acc[a][b][m][n] = (f32x4){0.f, 0.f, 0.f, 0.f};
        cur = nxt; cA = nA; cB = nB; ++ui;
    }
    PG8_WAIT_V(0);
    if (wr == 0) PG8_BAR;
    PG8_BAR;
#undef PG8_SA
#undef PG8_SB
#undef PG8_STAGE
#undef PG8_LDA
#undef PG8_LDB
#undef PG8_MMA
#undef PG8_WAIT_V
#undef PG8_WAIT_L
#undef PG8_BAR
#undef PG8_SCHED
}
}

__device__ __forceinline__ void transpose_tile(LAS float* tile, const float* __restrict__ src, int N, int k0, int n0, half_t* __restrict__ dst, int ldd, int drow0) {
    const int tid = threadIdx.x;
#pragma unroll
    for (int i = 0; i < 8; ++i) { const int kk = i * 8 + (tid >> 6), nn = tid & 63; tile[kk * 65 + nn] = src[(size_t)(k0 + kk) * N + n0 + nn]; }
    __syncthreads();
    { const int n = tid >> 3, kq = tid & 7; float v[8];
#pragma unroll
        for (int j = 0; j < 8; ++j) v[j] = tile[(kq * 8 + j) * 65 + n];
        u32x4 w; w.x = pk2h(v[0], v[1]); w.y = pk2h(v[2], v[3]); w.z = pk2h(v[4], v[5]); w.w = pk2h(v[6], v[7]);
        *(u32x4*)(dst + (size_t)(drow0 + n) * ldd + k0 + kq * 8) = w; }
    __syncthreads();
}

__device__ __forceinline__ void ln_row_to_f16(const float* __restrict__ xrow, const float* __restrict__ g, const float* __restrict__ b, half_t* __restrict__ orow, int lane) {
    f32x4 v[4]; float s = 0.f;
#pragma unroll
    for (int j = 0; j < 4; ++j) { v[j] = *(const f32x4*)(xrow + j * 256 + lane * 4); s += (v[j][0] + v[j][1]) + (v[j][2] + v[j][3]); }
    const float mu = wave_sum(s) * (1.0f / 1024.0f); float q = 0.f;
#pragma unroll
    for (int j = 0; j < 4; ++j) { v[j] = v[j] - mu; q += (v[j][0] * v[j][0] + v[j][1] * v[j][1]) + (v[j][2] * v[j][2] + v[j][3] * v[j][3]); }
    const float rstd = __builtin_amdgcn_rsqf(wave_sum(q) * (1.0f / 1024.0f) + LN_EPS);
#pragma unroll
    for (int j = 0; j < 4; ++j) { const f32x4 gg = *(const f32x4*)(g + j * 256 + lane * 4), bb = *(const f32x4*)(b + j * 256 + lane * 4); const f32x4 o = v[j] * rstd * gg + bb;
        u32x2 w; w.x = pk2h(o[0], o[1]); w.y = pk2h(o[2], o[3]); *(u32x2*)(orow + j * 256 + lane * 4) = w; }
}

__device__ void phase_prologue(LAS unsigned char* lds, const Params& P) {
    unsigned char* ws = P.ws;
    const int tid = threadIdx.x, G = gridDim.x, bx = blockIdx.x;
    LAS float* tile = (LAS float*)lds;
    const int T0 = 16 * 28, T1 = T0 + 16 * 16, T2 = T1 + 16 * 44, T3 = T2 + 16 * 44, T4 = T3 + 44 * 16, T5 = T4 + 16 * 16, T6 = T5 + 4 * 16;
    for (int t = bx; t < T0; t += G) {
        const float* src; int N, loc, ldd, kind = 0, ncols = 0; half_t* dst;
        if (t < T0) { src = P.in[4]; N = NIN; ncols = 1792; loc = t; dst = (half_t*)(ws + WS_WIN); ldd = DM; }
        else if (t < T1) { src = P.in[18]; N = DM; loc = t - T0; dst = (half_t*)(ws + WS_WOUT); ldd = DM; }
        else if (t < T2) { src = P.in[21]; N = DFF; loc = t - T1; dst = (half_t*)(ws + WS_WGU); ldd = DM; kind = 1; }
        else if (t < T3) { src = P.in[22]; N = DFF; loc = t - T2; dst = (half_t*)(ws + WS_WGU); ldd = DM; kind = 2; }
        else if (t < T4) { src = P.in[23]; N = DM; loc = t - T3; dst = (half_t*)(ws + WS_WDN); ldd = DFF; }
        else if (t < T5) { src = P.in[25]; N = DM; loc = t - T4; dst = (half_t*)(ws + WS_WPLG); ldd = DM; }
        else { src = P.in[24]; N = DM; loc = t - T5; dst = (half_t*)(ws + WS_WPLP); ldd = DPLE; }
        const int ntn = (ncols ? ncols : N) / 64, kt = loc / ntn, nt_ = loc % ntn, n0 = nt_ * 64;
        int drow0 = n0;
        if (kind) drow0 = (n0 >> 7) * 256 + (n0 & 127) + (kind == 2 ? 128 : 0);
        transpose_tile(tile, src, N, kt * 64, n0, dst, ldd, drow0);
    }
    const int gtid = bx * NTHREADS + tid, gth = G * NTHREADS;
    { half_t* wl = (half_t*)(ws + WS_WLORA);
        for (int i = gtid; i < 1536 * 256; i += gth) { const int n = i >> 8, k = i & 255; float v = 0.f;
            if (n < 512) { if (k < 64) v = P.in[7][k * 512 + n]; }
            else if (n < 1024) { if (k >= 64 && k < 128) v = P.in[9][(k - 64) * 512 + (n - 512)]; }
            else { if (k >= 128) v = P.in[10][(k - 128) * 512 + (n - 1024)]; }
            wl[i] = (half_t)v; } }
    { half_t* wt_in = (half_t*)(ws + WS_WIN); LAS float* Pw = (LAS float*)lds; LAS float* Wl = (LAS float*)(lds + 65536);
        for (int job = bx; job < 256; job += G) {
            const int g = job >> 6, k0 = (job & 63) * 16;
            __syncthreads();
            for (int i = tid; i < 4096; i += NTHREADS) *(LAS f32x4*)(Pw + i * 4) = *(const f32x4*)(P.in[16] + (size_t)g * 16384 + i * 4);
            { const int r = tid >> 5, c4 = (tid & 31) * 4; *(LAS f32x4*)(Wl + r * 128 + c4) = *(const f32x4*)(P.in[4] + (size_t)(k0 + r) * NIN + 1792 + g * 128 + c4); }
            __syncthreads();
            const int d = tid & 127, kr = tid >> 7; float acc[4] = {0.f, 0.f, 0.f, 0.f};
#pragma unroll 4
            for (int c = 0; c < 128; c += 4) {
                const float p0 = Pw[c * 128 + d], p1 = Pw[(c + 1) * 128 + d], p2 = Pw[(c + 2) * 128 + d], p3 = Pw[(c + 3) * 128 + d];
#pragma unroll
                for (int j = 0; j < 4; ++j) { const f32x4 wv = *(const LAS f32x4*)(Wl + (kr * 4 + j) * 128 + c); acc[j] += wv[0] * p0 + wv[1] * p1 + wv[2] * p2 + wv[3] * p3; } }
            u32x2 w; w.x = pk2h(acc[0], acc[1]); w.y = pk2h(acc[2], acc[3]);
            *(u32x2*)(wt_in + (size_t)(1792 + g * 128 + d) * DM + k0 + kr * 4) = w;
        }
        __syncthreads(); }
    { const int lane = tid & 63, wv = tid >> 6; half_t* h0 = (half_t*)(ws + WS_H0);
        f32x4 gg[4], bb[4];
#pragma unroll
        for (int j = 0; j < 4; ++j) { gg[j] = *(const f32x4*)(P.in[2] + j * 256 + lane * 4); bb[j] = *(const f32x4*)(P.in[3] + j * 256 + lane * 4); }
        for (int row = (bx * 8 + wv) * 2; row < MTOK; row += G * 16) {
            f32x4 v[2][4];
#pragma unroll
            for (int r = 0; r < 2; ++r)
#pragma unroll
                for (int j = 0; j < 4; ++j) v[r][j] = __builtin_nontemporal_load((const f32x4*)(P.in[0] + (size_t)(row + r) * DM + j * 256 + lane * 4));
#pragma unroll
            for (int r = 0; r < 2; ++r) {
                float s_ = 0.f;
#pragma unroll
                for (int j = 0; j < 4; ++j) s_ += (v[r][j][0] + v[r][j][1]) + (v[r][j][2] + v[r][j][3]);
                const float mu = wave_sum(s_) * (1.0f / 1024.0f); float q = 0.f;
#pragma unroll
                for (int j = 0; j < 4; ++j) { v[r][j] = v[r][j] - mu; q += (v[r][j][0] * v[r][j][0] + v[r][j][1] * v[r][j][1]) + (v[r][j][2] * v[r][j][2] + v[r][j][3] * v[r][j][3]); }
                const float rstd = __builtin_amdgcn_rsqf(wave_sum(q) * (1.0f / 1024.0f) + LN_EPS);
#pragma unroll
                for (int j = 0; j < 4; ++j) { const f32x4 o = v[r][j] * rstd * gg[j] + bb[j]; u32x2 w; w.x = pk2h(o[0], o[1]); w.y = pk2h(o[2], o[3]); *(u32x2*)(h0 + (size_t)(row + r) * DM + j * 256 + lane * 4) = w; }
            }
        }
    }
}

template <int W> __device__ __forceinline__ void pool_group(const half_t* __restrict__ Z, half_t* __restrict__ Y, const float* __restrict__ scale, int g, int gtid, int gth) {
    for (int i = gtid; i < MTOK * 16; i += gth) {
        const int m = i >> 4, jc = g * 16 + (i & 15), t = m & (SEQ - 1);
        const half_t* zp = Z + (size_t)m * NIN + 1792 + jc * 8;
        h8 u[W];
#pragma unroll
        for (int q = 0; q < W; ++q) { if (q <= t) u[q] = *(const h8*)(zp - (size_t)q * NIN); else u[q] = (h8){0, 0, 0, 0, 0, 0, 0, 0}; }
        const int cnt = (t + 1) < W ? (t + 1) : W; const float inv = 1.0f / (float)cnt; float r[8];
#pragma unroll
        for (int e = 0; e < 8; ++e) { float s = 0.f;
#pragma unroll
            for (int q = 0; q < W; ++q) s += (float)u[q][e];
            r[e] = (s * inv - (float)u[0][e]) * scale[jc * 8 + e]; }
        u32x4 w; w.x = pk2h(r[0], r[1]); w.y = pk2h(r[2], r[3]); w.z = pk2h(r[4], r[5]); w.w = pk2h(r[6], r[7]);
        *(u32x4*)(Y + (size_t)m * DM + 512 + jc * 8) = w;
    }
}
__device__ void phase_prep(const Params& P) {
    unsigned char* ws = P.ws;
    const half_t* Z = (const half_t*)(ws + WS_Z); half_t* AL = (half_t*)(ws + WS_AL); half_t* Yb = (half_t*)(ws + WS_Y);
    const float* mu = P.in[5];
    const int gtid = blockIdx.x * NTHREADS + threadIdx.x, gth = gridDim.x * NTHREADS;
    for (int i = gtid; i < MTOK * 32; i += gth) {
        const int m = i >> 5, j = i & 31, t = m & (SEQ - 1);
        const half_t* zrow = Z + (size_t)m * NIN;
        const int cz = 1536 + j * 8;
        const h8 zc = *(const h8*)(zrow + cz); h8 zp;
        if (t > 0) zp = *(const h8*)(zrow - NIN + cz); else zp = (h8){0, 0, 0, 0, 0, 0, 0, 0};
        const f32x4 m0 = *(const f32x4*)(mu + cz), m1 = *(const f32x4*)(mu + cz + 4); float r[8];
#pragma unroll
        for (int e = 0; e < 8; ++e) { const float zz = (float)zc[e], mm = e < 4 ? m0[e & 3] : m1[e & 3]; float v = zz + ((float)zp[e] - zz) * mm;
            if (j < 8) { const float tt = __builtin_amdgcn_exp2f(2.88539008f * v); v = 1.0f - 2.0f * __builtin_amdgcn_rcpf(1.0f + tt); }
            else if (j >= 16) v = sigm(v);
            r[e] = v; }
        u32x4 w; w.x = pk2h(r[0], r[1]); w.y = pk2h(r[2], r[3]); w.z = pk2h(r[4], r[5]); w.w = pk2h(r[6], r[7]);
        *(u32x4*)(AL + (size_t)m * 256 + j * 8) = w;
    }
    pool_group<2>(Z, Yb, P.in[17], 0, gtid, gth);
    pool_group<4>(Z, Yb, P.in[17], 1, gtid, gth);
    pool_group<8>(Z, Yb, P.in[17], 2, gtid, gth);
    pool_group<16>(Z, Yb, P.in[17], 3, gtid, gth);
}

constexpr int TC = 32;
constexpr int STEPF = 384;
constexpr int SC_BUF = 0, SC_SCAL = 2 * TC * STEPF * 4, SC_YB = SC_SCAL + 2 * TC * 4 * 4, SC_VR = SC_YB + 4 * 32 * 33 * 4, SC_BR = SC_VR + 4 * TC * 32 * 2, SC_CST = SC_BR + 4 * TC * 8, SC_END = SC_CST + 8 * 64 * 4;
static_assert(SC_END <= LDS_BYTES, "scan lds");

__device__ __forceinline__ float wave_sum_dpp(float v) {
    v = red16(v);
    v += __int_as_float(__builtin_amdgcn_update_dpp(0, __float_as_int(v), 0x142, 0xA, 0xF, false));
    v += __int_as_float(__builtin_amdgcn_update_dpp(0, __float_as_int(v), 0x143, 0xC, 0xF, false));
    return __int_as_float(__builtin_amdgcn_readlane(__float_as_int(v), 63));
}

struct ScanRaw { h8 zr, zk, zv, pr, pk, pv, lw, la; };
struct ScanStep { f32x4 kkA, kkB, wrA, wrB, wA, wB, k2A, k2B, bnA, bnB, sc; float vv; };

__device__ __forceinline__ void scan_load_raw(ScanRaw& R, const half_t* __restrict__ Z, const half_t* __restrict__ LO, size_t mb, int t, int hc8) {
    const half_t* zp = Z + (mb + t) * NIN + hc8; const half_t* lp = LO + (mb + t) * 1536 + hc8;
    R.zr = *(const h8*)(zp); R.zk = *(const h8*)(zp + 512); R.zv = *(const h8*)(zp + 1024); R.lw = *(const h8*)(lp); R.la = *(const h8*)(lp + 512);
    if (t > 0) { R.pr = *(const h8*)(zp - NIN); R.pk = *(const h8*)(zp - NIN + 512); R.pv = *(const h8*)(zp - NIN + 1024); }
    else { R.pr = (h8){0, 0, 0, 0, 0, 0, 0, 0}; R.pk = R.pr; R.pv = R.pr; }
}

#define SCAN_BAR() do { asm volatile("s_waitcnt lgkmcnt(0)" ::: "memory"); __builtin_amdgcn_s_barrier(); asm volatile("" ::: "memory"); } while (0)
__device__ void phase_scan(LAS unsigned char* lds, const Params& P) {
    unsigned char* ws = P.ws;
    const half_t* Z = (const half_t*)(ws + WS_Z); const half_t* LO = (const half_t*)(ws + WS_LO);
    unsigned long long* XS = (unsigned long long*)(ws + WS_XS); half_t* Y = (half_t*)(ws + WS_Y);
    const int tid = threadIdx.x, lane = tid & 63, wave = __builtin_amdgcn_readfirstlane(tid >> 6);
    LAS float* bufs = (LAS float*)(lds + SC_BUF); LAS float* scal = (LAS float*)(lds + SC_SCAL); LAS float* ybs = (LAS float*)(lds + SC_YB);
    LAS half_t* vring = (LAS half_t*)(lds + SC_VR); LAS float* bring = (LAS float*)(lds + SC_BR);
    for (int item = blockIdx.x; item < 256; item += gridDim.x) {
        const int half = item & 1, bh = item >> 1, h = bh & 7, b = bh >> 3;
        const size_t mb = (size_t)b * SEQ;
        LAS float* cst = (LAS float*)(lds + SC_CST);
        if (tid < 64) { const int hc = h * 64 + tid; cst[tid] = P.in[5][hc]; cst[64 + tid] = P.in[5][512 + hc]; cst[128 + tid] = P.in[5][1024 + hc]; cst[192 + tid] = P.in[6][hc];
            cst[256 + tid] = P.in[8][hc]; cst[320 + tid] = P.in[11][hc]; cst[384 + tid] = P.in[12][hc]; cst[448 + tid] = P.in[13][hc]; }
        __syncthreads();
        if (wave >= 4) {
            const int pw = wave - 4, s8 = lane >> 3, cg = lane & 7, hc8 = h * 64 + cg * 8, tt = pw * 8 + s8;
            const int ptid = tid - 256, ft = ptid >> 3, q = ptid & 7, oc = h * 64 + half * 32 + q * 4;
            const f32x4 lng = *(const f32x4*)(P.in[14] + oc), lnb = *(const f32x4*)(P.in[15] + oc);
            unsigned long long* xs_mine = XS + ((size_t)(bh * 2 + half)) * SEQ; const unsigned long long* xs_peer = XS + ((size_t)(bh * 2 + (half ^ 1))) * SEQ;
#define SCAN_Y4(fc) (f32x4){ybs[((fc) & 3) * (32 * 33) + (q * 4 + 0) * 33 + ft], ybs[((fc) & 3) * (32 * 33) + (q * 4 + 1) * 33 + ft], ybs[((fc) & 3) * (32 * 33) + (q * 4 + 2) * 33 + ft], ybs[((fc) & 3) * (32 * 33) + (q * 4 + 3) * 33 + ft]}
#define SCAN_PUBLISH(fc) do { f32x4 y4 = SCAN_Y4(fc); { const h4 vq_ = *(const LAS h4*)(vring + (((fc) & 3) * TC + ft) * 32 + q * 4); const float kr_ = bring[(((fc) & 3) * TC + ft) * 2 + 1]; \
                y4[0] += (float)vq_[0] * kr_; y4[1] += (float)vq_[1] * kr_; y4[2] += (float)vq_[2] * kr_; y4[3] += (float)vq_[3] * kr_; }     \
                float s1 = (y4[0] + y4[1]) + (y4[2] + y4[3]), s2 = (y4[0] * y4[0] + y4[1] * y4[1]) + (y4[2] * y4[2] + y4[3] * y4[3]); \
                s1 = red8(s1); s2 = red8(s2) + 1e-30f; \
                if (q == 0) __hip_atomic_store(xs_mine + (fc) * TC + ft, ((unsigned long long)__float_as_uint(s2) << 32) | __float_as_uint(s1), __ATOMIC_RELAXED, __HIP_MEMORY_SCOPE_AGENT); } while (0)
#define SCAN_FINAL_LOAD(fz, G4, PW) do { const int t_ = (fz) * TC + ft; G4 = *(const h4*)(LO + (mb + t_) * 1536 + 1024 + oc); PW = __hip_atomic_load(xs_peer + t_, __ATOMIC_RELAXED, __HIP_MEMORY_SCOPE_AGENT); } while (0)
#define SCAN_FINAL(fz, G4, PW) do { const int t_ = (fz) * TC + ft; f32x4 y4 = SCAN_Y4(fz); \
                const h4 v4 = *(const LAS h4*)(vring + (((fz) & 3) * TC + ft) * 32 + q * 4); const f32x2 bk_ = *(const LAS f32x2*)(bring + (((fz) & 3) * TC + ft) * 2); const float bon_ = bk_[0]; \
                y4[0] += (float)v4[0] * bk_[1]; y4[1] += (float)v4[1] * bk_[1]; y4[2] += (float)v4[2] * bk_[1]; y4[3] += (float)v4[3] * bk_[1]; \
                const h4 g4 = G4; unsigned long long pw_ = PW; \
                { unsigned sp_ = 0; while (pw_ == 0ull && ++sp_ < (1u << 22)) { __builtin_amdgcn_s_sleep(1); pw_ = __hip_atomic_load(xs_peer + t_, __ATOMIC_RELAXED, __HIP_MEMORY_SCOPE_AGENT); } } \
                float s1 = (y4[0] + y4[1]) + (y4[2] + y4[3]), s2 = (y4[0] * y4[0] + y4[1] * y4[1]) + (y4[2] * y4[2] + y4[3] * y4[3]); \
                s1 = red8(s1) + __uint_as_float((unsigned)pw_); s2 = red8(s2) + __uint_as_float((unsigned)(pw_ >> 32)); \
                const float mean = s1 * (1.0f / 64.0f), var = fmaxf(s2 * (1.0f / 64.0f) - mean * mean, 0.f), rstd = __builtin_amdgcn_rsqf(var + GN_EPS); \
                float o_[4]; \
                _Pragma("unroll") for (int j = 0; j < 4; ++j) o_[j] = ((y4[j] - mean) * rstd * lng[j] + lnb[j] + bon_ * (float)v4[j]) * (float)g4[j]; \
                u32x2 w2_; w2_.x = pk2h(o_[0], o_[1]); w2_.y = pk2h(o_[2], o_[3]); *(u32x2*)(Y + (mb + t_) * DM + oc) = w2_; } while (0)
            ScanRaw Ra, Rb;
            scan_load_raw(Ra, Z, LO, mb, tt, hc8);
#define SCAN_PROD_ITER(ch, CUR, NXT) do { \
                const int pc_ = (ch) + 1; \
                h4 fg4_ = (h4){0, 0, 0, 0}; unsigned long long fpw_ = 0ull; if ((ch) >= 2) SCAN_FINAL_LOAD((ch) - 2, fg4_, fpw_);     \
                  \
                float wv_[8]; half_t* wdst_ = nullptr; f32x4 pv_; const bool pdo_ = (pc_ < 64) && (ptid < 128); \
                if (pc_ < 64 && ptid < 84) { int it_ = item * 5376 + pc_ * 84 + ptid; const float* src_; half_t* db_; int N_, ldd_, kind_ = 0; \
                    if (it_ < 131072) { src_ = P.in[18]; db_ = (half_t*)(ws + WS_WOUT); N_ = DM; ldd_ = DM; } \
                    else if ((it_ -= 131072) < 360448) { src_ = P.in[21]; db_ = (half_t*)(ws + WS_WGU); N_ = DFF; ldd_ = DM; kind_ = 1; } \
                    else if ((it_ -= 360448) < 360448) { src_ = P.in[22]; db_ = (half_t*)(ws + WS_WGU); N_ = DFF; ldd_ = DM; kind_ = 2; } \
                    else if ((it_ -= 360448) < 360448) { src_ = P.in[23]; db_ = (half_t*)(ws + WS_WDN); N_ = DM; ldd_ = DFF; } \
                    else if ((it_ -= 360448) < 131072) { src_ = P.in[25]; db_ = (half_t*)(ws + WS_WPLG); N_ = DM; ldd_ = DM; } \
                    else { it_ -= 131072; src_ = P.in[24]; db_ = (half_t*)(ws + WS_WPLP); N_ = DM; ldd_ = DPLE; } \
                    const int kg_ = it_ / N_, n_ = it_ - kg_ * N_; \
                    const int row_ = kind_ ? ((n_ >> 7) * 256 + (n_ & 127) + (kind_ == 2 ? 128 : 0)) : n_; \
                    const float* sp_ = src_ + (size_t)(kg_ * 8) * N_ + n_; \
                    _Pragma("unroll") for (int e = 0; e < 8; ++e) wv_[e] = sp_[(size_t)e * N_]; \
                    wdst_ = db_ + (size_t)row_ * ldd_ + kg_ * 8; } \
                if (pdo_) pv_ = ((const f32x4*)P.in[1])[item * 8192 + pc_ * 128 + ptid]; \
                if (pc_ + 1 < 64) scan_load_raw(NXT, Z, LO, mb, (pc_ + 1) * TC + tt, hc8); \
                if (pc_ < 64) { \
                    LAS float* dst = bufs + (pc_ & 1) * (TC * STEPF) + tt * STEPF + cg * 8; LAS float* dsc = scal + (pc_ & 1) * (TC * 4); \
                    float kk[8], wr_[8], w_[8], k2[8], bn[8], vv_[8]; float ss = 0.f, brs = 0.f, krs = 0.f, bons = 0.f; \
                    float mu_r[8], mu_k[8], mu_v[8], w0c[8], a0c[8], kkc[8], kac[8], rkc[8]; \
                    _Pragma("unroll") for (int hf = 0; hf < 2; ++hf) { const LAS float* cp = cst + cg * 8 + hf * 4; \
                        const f32x4 c0 = *(const LAS f32x4*)(cp), c1 = *(const LAS f32x4*)(cp + 64), c2 = *(const LAS f32x4*)(cp + 128), c3 = *(const LAS f32x4*)(cp + 192), \
                                    c4 = *(const LAS f32x4*)(cp + 256), c5 = *(const LAS f32x4*)(cp + 320), c6 = *(const LAS f32x4*)(cp + 384), c7 = *(const LAS f32x4*)(cp + 448); \
                        _Pragma("unroll") for (int j = 0; j < 4; ++j) { mu_r[hf * 4 + j] = c0[j]; mu_k[hf * 4 + j] = c1[j]; mu_v[hf * 4 + j] = c2[j]; w0c[hf * 4 + j] = c3[j]; a0c[hf * 4 + j] = c4[j]; kkc[hf * 4 + j] = c5[j]; kac[hf * 4 + j] = c6[j]; rkc[hf * 4 + j] = c7[j]; } } \
                    _Pragma("unroll") for (int e = 0; e < 8; ++e) { \
                        const float r0 = (float)CUR.zr[e], k0 = (float)CUR.zk[e], v0 = (float)CUR.zv[e]; \
                        const float r = r0 + ((float)CUR.pr[e] - r0) * mu_r[e], k = k0 + ((float)CUR.pk[e] - k0) * mu_k[e]; vv_[e] = v0 + ((float)CUR.pv[e] - v0) * mu_v[e]; \
                        const float sg = sigm(w0c[e] + (float)CUR.lw[e]); \
                        const float w = __builtin_amdgcn_exp2f(-0.875057039f * sg); \
                        const float a = sigm(a0c[e] + (float)CUR.la[e]); \
                        const float kq = k * kkc[e]; ss += kq * kq; kk[e] = kq; \
                        k2[e] = k * (1.0f + (a - 1.0f) * kac[e]); \
                        bn[e] = -kq * a; brs += bn[e] * r; \
                        const float pr = k2[e] * r; krs += pr; bons += pr * rkc[e]; \
                        w_[e] = w; wr_[e] = w * r; } \
                    ss = red8(ss); brs = red8(brs); krs = red8(krs); bons = red8(bons); \
                    const float rn = __builtin_amdgcn_rsqf(fmaxf(ss, 1e-24f)); brs *= rn; \
                    _Pragma("unroll") for (int e = 0; e < 8; ++e) { kk[e] *= rn; bn[e] *= rn; } \
                    *(LAS f32x4*)(dst) = (f32x4){kk[0], kk[1], kk[2], kk[3]}; *(LAS f32x4*)(dst + 4) = (f32x4){kk[4], kk[5], kk[6], kk[7]}; \
                    *(LAS f32x4*)(dst + 64) = (f32x4){wr_[0], wr_[1], wr_[2], wr_[3]}; *(LAS f32x4*)(dst + 68) = (f32x4){wr_[4], wr_[5], wr_[6], wr_[7]}; \
                    *(LAS f32x4*)(dst + 128) = (f32x4){w_[0], w_[1], w_[2], w_[3]}; *(LAS f32x4*)(dst + 132) = (f32x4){w_[4], w_[5], w_[6], w_[7]}; \
                    *(LAS f32x4*)(dst + 192) = (f32x4){k2[0], k2[1], k2[2], k2[3]}; *(LAS f32x4*)(dst + 196) = (f32x4){k2[4], k2[5], k2[6], k2[7]}; \
                    *(LAS f32x4*)(dst + 256) = (f32x4){bn[0], bn[1], bn[2], bn[3]}; *(LAS f32x4*)(dst + 260) = (f32x4){bn[4], bn[5], bn[6], bn[7]}; \
                    *(LAS f32x4*)(dst + 320) = (f32x4){vv_[0], vv_[1], vv_[2], vv_[3]}; *(LAS f32x4*)(dst + 324) = (f32x4){vv_[4], vv_[5], vv_[6], vv_[7]}; \
                    if (cg == 0) { *(LAS f32x4*)(dsc + tt * 4) = (f32x4){brs, krs, bons, 0.f}; *(LAS f32x2*)(bring + ((pc_ & 3) * TC + tt) * 2) = (f32x2){bons, krs}; } \
                    if ((cg >> 2) == half) { u32x4 vw_; vw_.x = pk2h(vv_[0], vv_[1]); vw_.y = pk2h(vv_[2], vv_[3]); vw_.z = pk2h(vv_[4], vv_[5]); vw_.w = pk2h(vv_[6], vv_[7]); \
                        *(LAS u32x4*)(vring + ((pc_ & 3) * TC + tt) * 32 + (cg & 3) * 8) = vw_; } \
                } \
                if ((ch) >= 1) SCAN_PUBLISH((ch) - 1); \
                if ((ch) >= 2) SCAN_FINAL((ch) - 2, fg4_, fpw_); \
                if (wdst_) { u32x4 ww_; ww_.x = pk2h(wv_[0], wv_[1]); ww_.y = pk2h(wv_[2], wv_[3]); ww_.z = pk2h(wv_[4], wv_[5]); ww_.w = pk2h(wv_[6], wv_[7]); *(u32x4*)wdst_ = ww_; } \
                if (pdo_) { u32x2 pw2_; pw2_.x = pk2h(pv_[0], pv_[1]); pw2_.y = pk2h(pv_[2], pv_[3]); ((u32x2*)(ws + WS_P16))[item * 8192 + pc_ * 128 + ptid] = pw2_; } \
                __syncthreads(); \
            } while (0)
            for (int ch = -1; ch < 63; ch += 2) { SCAN_PROD_ITER(ch, Ra, Rb); SCAN_PROD_ITER(ch + 1, Rb, Ra); }
            SCAN_PROD_ITER(63, Ra, Rb);
#undef SCAN_PROD_ITER
            { h4 ga_, gb_; unsigned long long pa_, pb_; SCAN_FINAL_LOAD(62, ga_, pa_); SCAN_FINAL_LOAD(63, gb_, pb_); SCAN_PUBLISH(63); SCAN_FINAL(62, ga_, pa_); SCAN_FINAL(63, gb_, pb_); }
#undef SCAN_Y4
#undef SCAN_PUBLISH
#undef SCAN_FINAL
#undef SCAN_FINAL_LOAD
            __syncthreads();
        } else {
            const int row = wave * 8 + (lane >> 3), kl = lane & 7;
            f32x2 S0 = {0.f, 0.f}, S1 = {0.f, 0.f}, S2 = {0.f, 0.f}, S3 = {0.f, 0.f};
            __syncthreads();
            for (int ch = 0; ch < 64; ++ch) {
                const LAS float* src = bufs + (ch & 1) * (TC * STEPF); const LAS float* ssc = scal + (ch & 1) * (TC * 4); LAS float* yb = ybs + (ch & 3) * (32 * 33) + row * 33 + kl; float ykeep = 0.f;
                const LAS float* sbk = src + kl * 8; const LAS float* sbv = src + 320 + half * 32 + row;
#define SCAN_LOAD(Q, tt) do { const LAS float* sb = sbk + (tt) * STEPF; \
                    Q.kkA = *(const LAS f32x4*)(sb); Q.kkB = *(const LAS f32x4*)(sb + 4); Q.wrA = *(const LAS f32x4*)(sb + 64); Q.wrB = *(const LAS f32x4*)(sb + 68); \
                    Q.wA = *(const LAS f32x4*)(sb + 128); Q.wB = *(const LAS f32x4*)(sb + 132); Q.k2A = *(const LAS f32x4*)(sb + 192); Q.k2B = *(const LAS f32x4*)(sb + 196); \
                    Q.bnA = *(const LAS f32x4*)(sb + 256); Q.bnB = *(const LAS f32x4*)(sb + 260); Q.vv = sbv[(tt) * STEPF]; Q.sc = *(const LAS f32x4*)(ssc + (tt) * 4); } while (0)
#define SCAN_COMPUTE(Q, tt) do { \
                    f32x2 pa2 = S0 * (f32x2){Q.kkA[0], Q.kkA[1]}; pa2 = S1 * (f32x2){Q.kkA[2], Q.kkA[3]} + pa2; pa2 = S2 * (f32x2){Q.kkB[0], Q.kkB[1]} + pa2; pa2 = S3 * (f32x2){Q.kkB[2], Q.kkB[3]} + pa2; \
                    f32x2 py2 = S0 * (f32x2){Q.wrA[0], Q.wrA[1]}; py2 = S1 * (f32x2){Q.wrA[2], Q.wrA[3]} + py2; py2 = S2 * (f32x2){Q.wrB[0], Q.wrB[1]} + py2; py2 = S3 * (f32x2){Q.wrB[2], Q.wrB[3]} + py2; \
                    float pa = pa2[0] + pa2[1], py = py2[0] + py2[1]; \
                    pa = red8(pa); py = red8(py); \
                    const f32x2 vv2 = {Q.vv, Q.vv}, pav = {pa, pa}; \
                    S0 = S0 * (f32x2){Q.wA[0], Q.wA[1]} + vv2 * (f32x2){Q.k2A[0], Q.k2A[1]}; S0 = pav * (f32x2){Q.bnA[0], Q.bnA[1]} + S0; \
                    S1 = S1 * (f32x2){Q.wA[2], Q.wA[3]} + vv2 * (f32x2){Q.k2A[2], Q.k2A[3]}; S1 = pav * (f32x2){Q.bnA[2], Q.bnA[3]} + S1; \
                    S2 = S2 * (f32x2){Q.wB[0], Q.wB[1]} + vv2 * (f32x2){Q.k2B[0], Q.k2B[1]}; S2 = pav * (f32x2){Q.bnB[0], Q.bnB[1]} + S2; \
                    S3 = S3 * (f32x2){Q.wB[2], Q.wB[3]} + vv2 * (f32x2){Q.k2B[2], Q.k2B[3]}; S3 = pav * (f32x2){Q.bnB[2], Q.bnB[3]} + S3; \
                    { const float y_ = py + pa * Q.sc[0];                      ykeep = (kl == ((tt) & 7)) ? y_ : ykeep;     \
                      if (((tt) & 7) == 7) yb[(tt) - 7] = ykeep; } \
                } while (0)
                ScanStep q0, q1, q2;
                SCAN_LOAD(q0, 0); SCAN_LOAD(q1, 1);
#pragma unroll
                for (int tt = 0; tt < TC; tt += 3) {
                    if (tt + 2 < TC) SCAN_LOAD(q2, tt + 2);
                    __builtin_amdgcn_sched_barrier(0);
                    SCAN_COMPUTE(q0, tt);
                    if (tt + 1 < TC) { if (tt + 3 < TC) SCAN_LOAD(q0, tt + 3); __builtin_amdgcn_sched_barrier(0); SCAN_COMPUTE(q1, tt + 1); }
                    if (tt + 2 < TC) { if (tt + 4 < TC) SCAN_LOAD(q1, tt + 4); __builtin_amdgcn_sched_barrier(0); SCAN_COMPUTE(q2, tt + 2); }
                }
#undef SCAN_LOAD
#undef SCAN_COMPUTE
                __syncthreads();
            }
            __syncthreads();
        }
    }
}

__device__ void phase_ln1(const Params& P) {
    half_t* H1 = (half_t*)(P.ws + WS_H1);
    const int lane = threadIdx.x & 63, wv = threadIdx.x >> 6;
    for (int row = blockIdx.x * 8 + wv; row < MTOK; row += gridDim.x * 8) ln_row_to_f16(P.out + (size_t)row * DM, P.in[19], P.in[20], H1 + (size_t)row * DM, lane);
}
__device__ void phase_ln2(const Params& P) {
    const int lane = threadIdx.x & 63, wv = threadIdx.x >> 6;
    const float* g = P.in[26]; const float* b = P.in[27];
    for (int row = blockIdx.x * 8 + wv; row < MTOK; row += gridDim.x * 8) {
        float* xrow = P.out + (size_t)row * DM;
        f32x4 v[4]; float s = 0.f;
#pragma unroll
        for (int j = 0; j < 4; ++j) { v[j] = *(const f32x4*)(xrow + j * 256 + lane * 4); s += (v[j][0] + v[j][1]) + (v[j][2] + v[j][3]); }
        const float mu = wave_sum(s) * (1.0f / 1024.0f); float q = 0.f;
#pragma unroll
        for (int j = 0; j < 4; ++j) { v[j] = v[j] - mu; q += (v[j][0] * v[j][0] + v[j][1] * v[j][1]) + (v[j][2] * v[j][2] + v[j][3] * v[j][3]); }
        const float rstd = __builtin_amdgcn_rsqf(wave_sum(q) * (1.0f / 1024.0f) + LN_EPS);
#pragma unroll
        for (int j = 0; j < 4; ++j) { const f32x4 gg = *(const f32x4*)(g + j * 256 + lane * 4), bb = *(const f32x4*)(b + j * 256 + lane * 4);
            *(f32x4*)(xrow + j * 256 + lane * 4) = v[j] * rstd * gg + bb; }
    }
}

__global__ void __launch_bounds__(NTHREADS) fwd_megakernel(Params P) {
    extern __shared__ __attribute__((aligned(16))) unsigned char lds_raw[];
    LAS unsigned char* lds = (LAS unsigned char*)lds_raw;
    cg::grid_group grid = cg::this_grid();
    if (P.ph_hi < 0) grid.sync();
    volatile LAS unsigned* xst = (volatile LAS unsigned*)(lds + LDS_BYTES);
    if (threadIdx.x < 2) xst[threadIdx.x] = 0u;
    __syncthreads();
    XcdBarrier xbar = xcd_barrier_post((unsigned*)P.ws, xst);
    unsigned char* ws = P.ws;
    const int lo = P.ph_lo, hi = P.ph_hi, G = gridDim.x, bx = blockIdx.x;
#define IN(k) (lo <= (k) && (k) < hi)
#define REP(k) for (int rep_ = 0; rep_ < (((PROBE_DUP >> (k)) & 1) ? 2 : 1); ++rep_)
#ifndef PROBE_SYNCS
#define PROBE_SYNCS 0
#endif
#define SEAM(k) do { if (IN(k) && IN((k) + 1)) { xcd_barrier(xbar); for (int s_ = 0; s_ < PROBE_SYNCS; ++s_) xcd_barrier(xbar); } } while (0)
    if (IN(0)) REP(0) { phase_prologue(lds, P); } SEAM(0);
    if (IN(1)) REP(1) {
        pg8::Gemm g{(const half_t*)(ws + WS_H0), (const half_t*)(ws + WS_WIN), MTOK, NIN, DM}; pg8::StaticOrder S; S.init(MTOK, NIN, G, bx);
        pg8::EpiH E{(half_t*)(ws + WS_Z), NIN, 0, nullptr};
        pg8::gemm_phase<pg8::EpiH>(lds, g, S, E);
    } SEAM(1);
    if (IN(2)) REP(2) { phase_prep(P); } SEAM(2);
    if (IN(3)) REP(3) {
        { pg8::Gemm g{(const half_t*)(ws + WS_AL), (const half_t*)(ws + WS_WLORA), MTOK, 1536, 256}; pg8::StaticOrder S; S.init(MTOK, 1536, G, bx);
            pg8::EpiH E{(half_t*)(ws + WS_LO), 1536, 0, nullptr};
            pg8::gemm_phase<pg8::EpiH>(lds, g, S, E); }
    } SEAM(3);
    if (IN(4)) REP(4) { phase_scan(lds, P); } SEAM(4);
    LAS unsigned char* tl = lds + LDS_TAB;
    if (IN(6)) REP(6) {
        pg8::Gemm g{(const half_t*)(ws + WS_Y), (const half_t*)(ws + WS_WOUT), MTOK, DM, DM}; pg8::StaticOrder S; S.init(MTOK, DM, G, bx);
        pg8::PanelStats st{(unsigned long long*)(ws + WS_XB1), (unsigned*)(ws + CTL_CNT1), LN_EPS};
        pg8::EpiLN<false> E{(const half_t*)(ws + WS_H0), nullptr, P.in[19], P.in[20], (half_t*)(ws + WS_H1), nullptr, st, tl};
        pg8::gemm_phase<pg8::EpiLN<false>>(lds, g, S, E);
    } SEAM(6);
    if (IN(7)) REP(7) {
        { pg8::Gemm g{(const half_t*)(ws + WS_H1), (const half_t*)(ws + WS_WGU), MTOK, 2 * DFF, DM}; pg8::StaticOrder S; S.init(MTOK, 2 * DFF, G, bx);
            pg8::EpiSwiGLU E{(half_t*)(ws + WS_ACT), DFF};
            pg8::gemm_phase<pg8::EpiSwiGLU>(lds, g, S, E); }
        { pg8::Gemm g{(const half_t*)(ws + WS_P16), (const half_t*)(ws + WS_WPLP), MTOK, DM, DPLE}; pg8::StaticOrder S; S.init(MTOK, DM, G, bx);
            pg8::EpiH E{(half_t*)(ws + WS_E2), DM, 0, nullptr};
            pg8::gemm_phase<pg8::EpiH>(lds, g, S, E); }
        { pg8::Gemm g{(const half_t*)(ws + WS_H1), (const half_t*)(ws + WS_WPLG), MTOK, DM, DM}; pg8::StaticOrder S; S.init(MTOK, DM, G, bx);
            pg8::EpiE E{(half_t*)(ws + WS_E2), DM};
            pg8::gemm_phase<pg8::EpiE>(lds, g, S, E); }
    } SEAM(7);
    if (IN(8)) {
        pg8::Gemm g{(const half_t*)(ws + WS_ACT), (const half_t*)(ws + WS_WDN), MTOK, DM, DFF}; pg8::StaticOrder S; S.init(MTOK, DM, G, bx);
        pg8::PanelStats st{(unsigned long long*)(ws + WS_XB2), (unsigned*)(ws + CTL_CNT2), LN_EPS};
        pg8::EpiLN<true> E{(const half_t*)(ws + WS_H1), (const half_t*)(ws + WS_E2), P.in[26], P.in[27], nullptr, P.out, st, tl};
        pg8::gemm_phase<pg8::EpiLN<true>>(lds, g, S, E);
    }
#undef IN
#undef SEAM
}

extern "C" void kernel_launch(void* const* d_in, const int* in_sizes, int n_in, void* d_out, int out_size, void* d_ws, size_t ws_size, hipStream_t stream) {
    static int grid_blocks = 0;
    if (grid_blocks == 0) {
        if (n_in != 28 || out_size != MTOK * DM || ws_size < WS_END) { fprintf(stderr, "kernel_launch: unexpected shapes (n_in %d, out %d, ws %zu, need %zu)\n", n_in, out_size, ws_size, (size_t)WS_END); grid_blocks = -1; return; }
        int dev = 0, cus = 0, per_cu = 0;
        (void)hipGetDevice(&dev);
        (void)hipDeviceGetAttribute(&cus, hipDeviceAttributeMultiprocessorCount, dev);
        if (hipFuncSetAttribute((const void*)fwd_megakernel, hipFuncAttributeMaxDynamicSharedMemorySize, LDS_TOTAL) != hipSuccess) { fprintf(stderr, "kernel_launch: hipFuncSetAttribute failed\n"); grid_blocks = -1; return; }
        if (hipOccupancyMaxActiveBlocksPerMultiprocessor(&per_cu, (const void*)fwd_megakernel, NTHREADS, LDS_TOTAL) != hipSuccess || per_cu < 1) { fprintf(stderr, "kernel_launch: occupancy query failed (%d)\n", per_cu); per_cu = 1; (void)hipGetLastError(); }
        grid_blocks = cus * per_cu;
    }
    if (grid_blocks < 0) return;
    Params p{};
    for (int i = 0; i < 28; ++i) p.in[i] = (const float*)d_in[i];
    p.out = (float*)d_out; p.ws = (unsigned char*)d_ws;
    static_assert(WS_XS == CTL_BYTES && WS_XS + XS_BYTES <= WS_WIN, "control words and exchange slots are one contiguous region");
    (void)hipMemsetAsync(d_ws, 0, CTL_BYTES + XS_BYTES, stream);
#if N_LAUNCH_MODE == 1
    p.ph_lo = 0; p.ph_hi = NPHASE;
    { void* args[] = {&p};
        hipError_t e = hipLaunchCooperativeKernel((const void*)fwd_megakernel, dim3(grid_blocks), dim3(NTHREADS), args, LDS_TOTAL, stream);
        if (e != hipSuccess) fprintf(stderr, "cooperative launch failed: %s (grid %d)\n", hipGetErrorString(e), grid_blocks); }
#else
    for (int ph = 0; ph < NPHASE; ++ph) {
        p.ph_lo = ph; p.ph_hi = ph + 1;
        void* args[] = {&p};
        hipError_t e = hipLaunchCooperativeKernel((const void*)fwd_megakernel, dim3(grid_blocks), dim3(NTHREADS), args, LDS_TOTAL, stream);
        if (e != hipSuccess) { fprintf(stderr, "launch %d failed: %s (grid %d)\n", ph, hipGetErrorString(e), grid_blocks); break; }
    }
#endif
}
```

```cpp
#include <hip/hip_runtime.h>
#include <hip/hip_cooperative_groups.h>
#include <cstdio>
namespace cg = cooperative_groups;

#ifndef N_LAUNCH_MODE
#define N_LAUNCH_MODE 1
#endif

#ifndef PROBE_DUP
#define PROBE_DUP 0
#endif
#define LAS __attribute__((address_space(3)))
typedef _Float16 half_t;
typedef _Float16 h8 __attribute__((ext_vector_type(8)));
typedef _Float16 h4 __attribute__((ext_vector_type(4)));
typedef _Float16 h2 __attribute__((ext_vector_type(2)));
typedef float f32x4 __attribute__((ext_vector_type(4)));
typedef float f32x2 __attribute__((ext_vector_type(2)));
typedef unsigned u32x4 __attribute__((ext_vector_type(4)));
typedef unsigned u32x2 __attribute__((ext_vector_type(2)));
typedef unsigned long long u64x2 __attribute__((ext_vector_type(2)));

constexpr int MTOK = 32768, SEQ = 2048, DM = 1024, NIN = 2304, RWW = 512, DFF = 2816, DPLE = 256, NH = 8;
constexpr float ALPHA = 1.189207115f;
constexpr float LN_EPS = 1e-5f, GN_EPS = 64e-5f;
constexpr int NTHREADS = 512;
constexpr int LDS_BYTES = 131072;
constexpr int LDS_TAB = LDS_BYTES + 64;
constexpr int LDS_TOTAL = LDS_TAB + 10240 + 64;
constexpr int NPHASE = 9;

constexpr size_t MiB = 1024 * 1024;
constexpr size_t WS_WIN = 5 * MiB;
constexpr size_t WS_WOUT = WS_WIN + (size_t)NIN * DM * 2;
constexpr size_t WS_WGU = WS_WOUT + (size_t)DM * DM * 2;
constexpr size_t WS_WDN = WS_WGU + (size_t)2 * DFF * DM * 2;
constexpr size_t WS_WPLG = WS_WDN + (size_t)DM * DFF * 2;
constexpr size_t WS_WPLP = WS_WPLG + (size_t)DM * DM * 2;
constexpr size_t WS_WLORA = WS_WPLP + (size_t)DM * DPLE * 2;
constexpr size_t WS_WPOOL = WS_WLORA + (size_t)1536 * 256 * 2;
constexpr size_t WS_WEND = WS_WPOOL + (size_t)512 * 512 * 2;
static_assert(WS_WEND <= 32 * MiB, "weights region");
constexpr size_t WS_BON = 30 * MiB;
constexpr size_t WS_H0 = 32 * MiB;
constexpr size_t WS_Z = 96 * MiB;
constexpr size_t WS_LO = 240 * MiB;
constexpr size_t WS_AL = 336 * MiB;
constexpr size_t WS_DP = 352 * MiB;
constexpr size_t WS_P16 = 384 * MiB;
constexpr size_t WS_Y = 400 * MiB;
constexpr size_t WS_XB1 = 464 * MiB;
constexpr size_t WS_XB2 = 465 * MiB;
constexpr size_t WS_XS = 128 * 1024;
constexpr size_t XS_BYTES = (size_t)128 * 2 * SEQ * 8;
constexpr size_t WS_END = 498 * MiB;
constexpr size_t CTL_CNT1 = 65536, CTL_CNT2 = 65536 + 32768, CTL_BYTES = 131072;
constexpr size_t WS_H1 = WS_Z;
constexpr size_t WS_ACT = WS_Z + 64 * MiB;
constexpr size_t WS_E2 = WS_Y;
static_assert(WS_ACT + (size_t)MTOK * DFF * 2 <= WS_AL, "ACT alias");

struct Params {
    const float* in[28];
    float* out;
    unsigned char* ws;
    int ph_lo, ph_hi;
};

__device__ __forceinline__ unsigned pk2h(float a, float b) { h2 v; v.x = (_Float16)a; v.y = (_Float16)b; return __builtin_bit_cast(unsigned, v); }
__device__ __forceinline__ float sigm(float x) { return __builtin_amdgcn_rcpf(1.0f + __builtin_amdgcn_exp2f(-1.44269504f * x)); }
template <int CTRL> __device__ __forceinline__ float dpp_get(float v) { return __int_as_float(__builtin_amdgcn_update_dpp(0, __float_as_int(v), CTRL, 0xF, 0xF, false)); }
__device__ __forceinline__ float red8(float v) { v += dpp_get<0xB1>(v); v += dpp_get<0x4E>(v); v += dpp_get<0x141>(v); return v; }
__device__ __forceinline__ float red16(float v) { v = red8(v); v += dpp_get<0x140>(v); return v; }
__device__ __forceinline__ float wave_sum(float v) { v = red16(v); v += __shfl_xor(v, 16); v += __shfl_xor(v, 32); return v; }


#define XB_TMO      128
#define XB_XCNT(j)  (256  + 64 * (j))
#define XB_XSUB(j)  (1280 + 64 * (j))
#define XB_XGEN(j)  (2304 + 64 * (j))
#define XB_TOP      3328
#define XB_TOPGEN   3392
#define XCD_BAR_WORDS 3456
#define XB_SPIN_CAP (1u << 20)
__device__ __forceinline__ unsigned xb_ld(unsigned* p)              { return __hip_atomic_load(p, __ATOMIC_RELAXED, __HIP_MEMORY_SCOPE_AGENT); }
__device__ __forceinline__ unsigned xb_add(unsigned* p, unsigned v) { return __hip_atomic_fetch_add(p, v, __ATOMIC_RELAXED, __HIP_MEMORY_SCOPE_AGENT); }
__device__ __forceinline__ unsigned xb_xcc_id() { return (unsigned)__builtin_amdgcn_s_getreg((3 << 11) | 20) & 0xFu; }
#define XB_SPIN(cond, bar) do { unsigned _sp = 0; while (cond) { __builtin_amdgcn_s_sleep(1); \
    if ((++_sp & 255u) == 0u) { if (xb_ld(&(bar)[XB_TMO])) break; if (_sp > XB_SPIN_CAP) { atomicAdd(&(bar)[XB_TMO], 1u); break; } } } } while (0)
struct XcdBarrier { unsigned* bar; unsigned x; volatile LAS unsigned* st; };
__device__ __forceinline__ XcdBarrier xcd_barrier_post(unsigned* bar, volatile LAS unsigned* st) {
    XcdBarrier b; b.bar = bar; b.x = xb_xcc_id(); b.st = st;
    if (threadIdx.x == 0) (void)xb_add(&bar[XB_XCNT(b.x)], 1u);
    return b;
}
__device__ __forceinline__ void xcd_barrier_complete(unsigned* bar, unsigned x, unsigned& nloc, unsigned& nx) {
    const unsigned G = gridDim.x * gridDim.y * gridDim.z;
    unsigned sum, cnt, mine, sp = 0u;
    for (;;) {
        sum = 0u; cnt = 0u; mine = 0u;
#pragma unroll
        for (unsigned j = 0; j < 16; ++j) { const unsigned c = xb_ld(&bar[XB_XCNT(j)]); sum += c; cnt += (c > 0u) ? 1u : 0u; mine = (j == x) ? c : mine; }
        if (sum == G) break;
        __builtin_amdgcn_s_sleep(1);
        if ((++sp & 255u) == 0u) { if (xb_ld(&bar[XB_TMO])) break; if (sp > XB_SPIN_CAP) { atomicAdd(&bar[XB_TMO], 1u); break; } }
    }
    nloc = mine > 0u ? mine : 1u; nx = cnt > 0u ? cnt : 1u;
}
__device__ __forceinline__ void xcd_barrier(const XcdBarrier& b) {
    asm volatile("s_waitcnt vmcnt(0)" ::: "memory");
    __syncthreads();
    if (threadIdx.x == 0) {
        unsigned* bar = b.bar;
        __builtin_amdgcn_s_waitcnt(0);
        unsigned nloc = b.st[0], nx = b.st[1];
        if (nloc == 0u) { xcd_barrier_complete(bar, b.x, nloc, nx); b.st[0] = nloc; b.st[1] = nx; }
        const unsigned old = xb_add(&bar[XB_XSUB(b.x)], 1u);
        const unsigned gen = old / nloc;
        if (old + 1u == (gen + 1u) * nloc) {
            __builtin_amdgcn_fence(__ATOMIC_RELEASE, "agent");
            asm volatile("s_waitcnt vmcnt(0)" ::: "memory");
            const unsigned og = xb_add(&bar[XB_TOP], 1u);
            const unsigned tg = og / nx;
            if (og + 1u == (tg + 1u) * nx) xb_add(&bar[XB_TOPGEN], 1u);
            else XB_SPIN(xb_ld(&bar[XB_TOPGEN]) == tg, bar);
            __builtin_amdgcn_fence(__ATOMIC_ACQUIRE, "agent");
            xb_add(&bar[XB_XGEN(b.x)], 1u);
            asm volatile("s_waitcnt vmcnt(0)" ::: "memory");
        } else {
            XB_SPIN(xb_ld(&bar[XB_XGEN(b.x)]) == gen, bar);
            __builtin_amdgcn_fence(__ATOMIC_ACQUIRE, "agent");
            asm volatile("s_waitcnt vmcnt(0)" ::: "memory");
        }
    }
    __syncthreads();
}

namespace pg8 {
constexpr int BM = 256, BK = 64, HALF = 128, HTB = HALF * BK * 2, STAGE_BYTES = 8 * HTB, NXCD = 8, WGM = 8;
__device__ __forceinline__ int lds_byte(int r, int c) { const int st = (r >> 4) * 2 + (c >> 5), rr = r & 15, cc = c & 31, ob = rr * 64 + cc * 2; return st * 1024 + (ob ^ (((ob >> 9) & 1) << 5)); }
__device__ __forceinline__ void stage_rc(int b, int& R, int& C) { const int st = b / 1024, sb = b % 1024, swz = sb ^ (((sb >> 9) & 1) << 5); R = (st >> 1) * 16 + swz / 64; C = (st & 1) * 32 + (swz % 64) / 2; }
__device__ __forceinline__ int perm32(int rho) { const int n = rho >> 4, i = rho & 15; return 8 * (i >> 2) + 4 * n + (i & 3); }

struct Unit { int pm, pn; };
struct Gemm { const half_t* A; const half_t* Bt; int M, N, K; };
struct StaticOrder {
    int nM, nN, nwg, G, c;
    __device__ void init(int M, int N, int G_, int c_) { nM = M / BM; nN = N / BM; nwg = nM * nN; G = G_; c = c_; }
    __device__ bool next(int i, Unit& u) const {
        const long L = (long)i * G + c; if (L >= nwg) return false;
        int wgid = (int)L; { const int q = nwg / NXCD, r = nwg % NXCD, xcd = wgid % NXCD, off = wgid / NXCD; wgid = (xcd < r ? xcd * (q + 1) : r * (q + 1) + (xcd - r) * q) + off; }
        const int nig = WGM * nN, gid = wgid / nig, fm = gid * WGM, gsz = (nM - fm) < WGM ? (nM - fm) : WGM;
        u.pm = fm + ((wgid % nig) % gsz); u.pn = (wgid % nig) / gsz; return true;
    }
};


struct EpiH {
    static constexpr bool PERM = true, SYNC = false;
    half_t* O; int ldc; int coff; const float* scale;
    __device__ __forceinline__ void operator()(const f32x4 (&acc)[2][2][4][2], const Unit& u, int wr, int wc, int fr, int fq) const {
        const int row0 = u.pm * BM + wr * 64 + fr, col0 = u.pn * BM + wc * 32 + 8 * fq;
        f32x4 sv[2][2];
#pragma unroll
        for (int bj = 0; bj < 2; ++bj)
#pragma unroll
            for (int n = 0; n < 2; ++n) sv[bj][n] = scale ? *(const f32x4*)(scale + col0 + bj * HALF + 4 * n) : (f32x4){1.f, 1.f, 1.f, 1.f};
#pragma unroll
        for (int ai = 0; ai < 2; ++ai)
#pragma unroll
            for (int m = 0; m < 4; ++m) { half_t* rowp = O + (size_t)(row0 + ai * HALF + m * 16) * ldc + coff + col0;
#pragma unroll
                for (int bj = 0; bj < 2; ++bj) { const f32x4 v0 = acc[ai][bj][m][0] * sv[bj][0], v1 = acc[ai][bj][m][1] * sv[bj][1];
                    u32x4 w; w.x = pk2h(v0[0], v0[1]); w.y = pk2h(v0[2], v0[3]); w.z = pk2h(v1[0], v1[1]); w.w = pk2h(v1[2], v1[3]);
                    *(u32x4*)(rowp + bj * HALF) = w; } }
    }
};
struct EpiSwiGLU {
    static constexpr bool PERM = true, SYNC = false;
    half_t* O; int ldc;
    __device__ __forceinline__ void operator()(const f32x4 (&acc)[2][2][4][2], const Unit& u, int wr, int wc, int fr, int fq) const {
        const int row0 = u.pm * BM + wr * 64 + fr, col0 = u.pn * HALF + wc * 32 + 8 * fq;
#pragma unroll
        for (int ai = 0; ai < 2; ++ai)
#pragma unroll
            for (int m = 0; m < 4; ++m) { half_t* rowp = O + (size_t)(row0 + ai * HALF + m * 16) * ldc + col0;
                float r[8];
#pragma unroll
                for (int n = 0; n < 2; ++n)
#pragma unroll
                    for (int j = 0; j < 4; ++j) { const float g = acc[ai][0][m][n][j], up = acc[ai][1][m][n][j]; r[n * 4 + j] = g * sigm(g) * up; }
                u32x4 w; w.x = pk2h(r[0], r[1]); w.y = pk2h(r[2], r[3]); w.z = pk2h(r[4], r[5]); w.w = pk2h(r[6], r[7]);
                *(u32x4*)rowp = w; }
    }
};
struct EpiE {
    static constexpr bool PERM = true, SYNC = false;
    half_t* E; int ldc;
    __device__ __forceinline__ void operator()(const f32x4 (&acc)[2][2][4][2], const Unit& u, int wr, int wc, int fr, int fq) const {
        const int row0 = u.pm * BM + wr * 64 + fr, col0 = u.pn * BM + wc * 32 + 8 * fq;
#pragma unroll
        for (int ai = 0; ai < 2; ++ai)
#pragma unroll
            for (int m = 0; m < 4; ++m) { half_t* rowp = E + (size_t)(row0 + ai * HALF + m * 16) * ldc + col0;
#pragma unroll
                for (int bj = 0; bj < 2; ++bj) {
                    const unsigned long long* ep = (const unsigned long long*)(rowp + bj * HALF);
                    u64x2 e01; e01.x = __hip_atomic_load(ep, __ATOMIC_RELAXED, __HIP_MEMORY_SCOPE_AGENT); e01.y = __hip_atomic_load(ep + 1, __ATOMIC_RELAXED, __HIP_MEMORY_SCOPE_AGENT);
                    const h8 e = __builtin_bit_cast(h8, e01); float r[8];
#pragma unroll
                    for (int n = 0; n < 2; ++n)
#pragma unroll
                        for (int j = 0; j < 4; ++j) r[n * 4 + j] = sigm(acc[ai][bj][m][n][j]) * (float)e[n * 4 + j];
                    u32x4 w; w.x = pk2h(r[0], r[1]); w.y = pk2h(r[2], r[3]); w.z = pk2h(r[4], r[5]); w.w = pk2h(r[6], r[7]);
                    *(u32x4*)(rowp + bj * HALF) = w; } }
    }
};
template <bool HAS2> struct EpiRes {
    static constexpr bool PERM = false, SYNC = false;
    float* C; const half_t* R1; const half_t* R2; int ldc;
    __device__ __forceinline__ void operator()(const f32x4 (&acc)[2][2][4][2], const Unit& u, int wr, int wc, int fr, int fq) const {
        const int row0 = u.pm * BM + wr * 64 + fr, col0 = u.pn * BM + wc * 32 + 4 * fq;
#pragma unroll
        for (int ai = 0; ai < 2; ++ai)
#pragma unroll
            for (int m = 0; m < 4; ++m) { const size_t off = (size_t)(row0 + ai * HALF + m * 16) * ldc + col0;
#pragma unroll
                for (int bj = 0; bj < 2; ++bj)
#pragma unroll
                    for (int n = 0; n < 2; ++n) { const size_t o = off + bj * HALF + n * 16; const h4 a = *(const h4*)(R1 + o);
                        f32x4 v = acc[ai][bj][m][n]; v[0] += ALPHA * (float)a[0]; v[1] += ALPHA * (float)a[1]; v[2] += ALPHA * (float)a[2]; v[3] += ALPHA * (float)a[3];
                        if (HAS2) { const h4 e = *(const h4*)(R2 + o); v[0] += (float)e[0]; v[1] += (float)e[1]; v[2] += (float)e[2]; v[3] += (float)e[3]; }
                        *(f32x4*)(C + o) = v; } }
    }
};


struct PanelStats {
    unsigned long long* xbuf; unsigned* cnt; float eps;
    __device__ __forceinline__ void run(const f32x4 (&v)[2][2][4][2], const Unit& u, int wr, int wc, int fr, int fq, LAS unsigned char* tl, int wid, int lane) const {
        LAS f32x2* Pt = (LAS f32x2*)tl; LAS f32x2* St = (LAS f32x2*)(tl + 8192);
#pragma unroll
        for (int ai = 0; ai < 2; ++ai)
#pragma unroll
            for (int m = 0; m < 4; ++m) {
                float s = 0.f;
#pragma unroll
                for (int bj = 0; bj < 2; ++bj)
#pragma unroll
                    for (int n = 0; n < 2; ++n) { const f32x4 x = v[ai][bj][m][n]; s += (x[0] + x[1]) + (x[2] + x[3]); }
                s += __shfl_xor(s, 16); s += __shfl_xor(s, 32);
                const float mw = s * (1.0f / 64.0f); float q = 0.f;
#pragma unroll
                for (int bj = 0; bj < 2; ++bj)
#pragma unroll
                    for (int n = 0; n < 2; ++n) { const f32x4 d = v[ai][bj][m][n] - mw; q += (d[0] * d[0] + d[1] * d[1]) + (d[2] * d[2] + d[3] * d[3]); }
                q += __shfl_xor(q, 16); q += __shfl_xor(q, 32);
                if (fq == 0) Pt[(ai * HALF + wr * 64 + m * 16 + fr) * 4 + wc] = (f32x2){mw, q};
            }
        asm volatile("s_waitcnt lgkmcnt(0)" ::: "memory"); __builtin_amdgcn_s_barrier(); asm volatile("" ::: "memory");
        const int row = wid * 32 + (lane & 31);
        if (lane < 32) {
            const f32x2 a = Pt[row * 4 + 0], b = Pt[row * 4 + 1], c = Pt[row * 4 + 2], d = Pt[row * 4 + 3];
            const float mt = (a.x + b.x + c.x + d.x) * 0.25f;
            const float da = a.x - mt, db = b.x - mt, dc = c.x - mt, dd = d.x - mt;
            const float m2 = (a.y + b.y) + (c.y + d.y) + 64.0f * ((da * da + db * db) + (dc * dc + dd * dd));
            unsigned long long* slot = xbuf + ((size_t)(u.pm * BM + row) * 4 + u.pn);
            __hip_atomic_store(slot, ((unsigned long long)__float_as_uint(m2) << 32) | __float_as_uint(mt), __ATOMIC_RELAXED, __HIP_MEMORY_SCOPE_AGENT);
        }
        asm volatile("s_waitcnt vmcnt(0)" ::: "memory");
        if (lane == 0) __hip_atomic_fetch_add(cnt + 64 * u.pm, 1u, __ATOMIC_RELAXED, __HIP_MEMORY_SCOPE_AGENT);
        if (wid == 0) {
            unsigned sp = 0;
            while ((unsigned)__builtin_amdgcn_readfirstlane(__hip_atomic_load(cnt + 64 * u.pm, __ATOMIC_RELAXED, __HIP_MEMORY_SCOPE_AGENT)) < 32u) { __builtin_amdgcn_s_sleep(2); if (++sp > (1u << 22)) break; }
            __builtin_amdgcn_fence(__ATOMIC_ACQUIRE, "agent");
        }
        asm volatile("s_waitcnt vmcnt(0) lgkmcnt(0)" ::: "memory"); __builtin_amdgcn_s_barrier(); asm volatile("" ::: "memory");
        if (lane < 32) {
            const unsigned long long* slot = xbuf + (size_t)(u.pm * BM + row) * 4; float mt[4], m2[4]; float ms = 0.f;
#pragma unroll
            for (int t = 0; t < 4; ++t) { const unsigned long long w = __hip_atomic_load(slot + t, __ATOMIC_RELAXED, __HIP_MEMORY_SCOPE_AGENT); mt[t] = __uint_as_float((unsigned)w); m2[t] = __uint_as_float((unsigned)(w >> 32)); ms += mt[t]; }
            const float mean = ms * 0.25f; float q = 0.f;
#pragma unroll
            for (int t = 0; t < 4; ++t) { const float dm = mt[t] - mean; q += m2[t] + 256.0f * dm * dm; }
            St[row] = (f32x2){mean, __builtin_amdgcn_rsqf(q * (1.0f / 1024.0f) + eps)};
        }
        asm volatile("s_waitcnt lgkmcnt(0)" ::: "memory"); __builtin_amdgcn_s_barrier(); asm volatile("" ::: "memory");
    }
};
template <bool FINAL> struct EpiLN {
    static constexpr bool PERM = false, SYNC = true;
    const half_t* R1; const half_t* R2; const float* g; const float* b; half_t* H; float* C; PanelStats st; LAS unsigned char* tl;
    __device__ __forceinline__ void operator()(f32x4 (&acc)[2][2][4][2], const Unit& u, int wr, int wc, int fr, int fq) const {
        const int lane = threadIdx.x & 63, wid = __builtin_amdgcn_readfirstlane(threadIdx.x >> 6);
        const int row0 = u.pm * BM + wr * 64 + fr, col0 = u.pn * BM + wc * 32 + 4 * fq;
#pragma unroll
        for (int ai = 0; ai < 2; ++ai)
#pragma unroll
            for (int m = 0; m < 4; ++m) { const size_t off = (size_t)(row0 + ai * HALF + m * 16) * DM + col0;
#pragma unroll
                for (int bj = 0; bj < 2; ++bj)
#pragma unroll
                    for (int n = 0; n < 2; ++n) { const size_t o = off + bj * HALF + n * 16; const h4 a = *(const h4*)(R1 + o);
                        f32x4 v = acc[ai][bj][m][n]; v[0] += ALPHA * (float)a[0]; v[1] += ALPHA * (float)a[1]; v[2] += ALPHA * (float)a[2]; v[3] += ALPHA * (float)a[3];
                        if (FINAL) { const h4 e = *(const h4*)(R2 + o); v[0] += (float)e[0]; v[1] += (float)e[1]; v[2] += (float)e[2]; v[3] += (float)e[3]; }
                        acc[ai][bj][m][n] = v; }
                asm volatile("" : "+v"(acc[ai][0][m][0]), "+v"(acc[ai][0][m][1]), "+v"(acc[ai][1][m][0]), "+v"(acc[ai][1][m][1]));
                asm volatile("" ::: "memory"); }
        f32x4 gvv[2][2], bvv[2][2];
#pragma unroll
        for (int bj = 0; bj < 2; ++bj)
#pragma unroll
            for (int n = 0; n < 2; ++n) { gvv[bj][n] = *(const f32x4*)(g + col0 + bj * HALF + n * 16); bvv[bj][n] = *(const f32x4*)(b + col0 + bj * HALF + n * 16); }
        st.run(acc, u, wr, wc, fr, fq, tl, wid, lane);
        const LAS f32x2* St = (const LAS f32x2*)(tl + 8192);
#pragma unroll
        for (int ai = 0; ai < 2; ++ai)
#pragma unroll
            for (int m = 0; m < 4; ++m) { const int r = ai * HALF + wr * 64 + m * 16 + fr; const f32x2 sr = St[r]; const size_t off = (size_t)(u.pm * BM + r) * DM + col0;
#pragma unroll
                for (int bj = 0; bj < 2; ++bj)
#pragma unroll
                    for (int n = 0; n < 2; ++n) {
                        const f32x4 o = (acc[ai][bj][m][n] - sr.x) * sr.y * gvv[bj][n] + bvv[bj][n]; const size_t oo = off + bj * HALF + n * 16;
                        if (FINAL) *(f32x4*)(C + oo) = o;
                        else { u32x2 w; w.x = pk2h(o[0], o[1]); w.y = pk2h(o[2], o[3]); *(u32x2*)(H + oo) = w; } }
                asm volatile("" ::: "memory"); }
        asm volatile("s_waitcnt lgkmcnt(0)" ::: "memory"); __builtin_amdgcn_s_barrier(); asm volatile("" ::: "memory");
    }
};

template <class Epi>
__device__ __forceinline__ void gemm_phase(LAS unsigned char* lds, const Gemm g, const StaticOrder& S, const Epi& E) {
    const int tid = threadIdx.x, wid = __builtin_amdgcn_readfirstlane(tid >> 6), lane = tid & 63, wr = wid >> 2, wc = wid & 3, fr = lane & 15, fq = lane >> 4;
    const int K = g.K, nt = K / BK;
    unsigned voffA[2], voffB[2];
#pragma unroll
    for (int i = 0; i < 2; ++i) { int R, C; stage_rc(tid * 16 + i * 8192, R, C); const int Rb = Epi::PERM ? ((R & ~31) + perm32(R & 31)) : R;
        voffA[i] = (unsigned)(R * K + C) * 2u; voffB[i] = (unsigned)(Rb * K + C) * 2u; }
    const size_t kstep = (size_t)(BK * 2);
    const size_t hstep = (size_t)HALF * K * 2;
    const size_t tstep = 2 * hstep;
    const unsigned ldsw = (unsigned)wid * 1024u;
    const int aoff = lds_byte(wr * 64 + fr, fq * 8), boff = lds_byte(wc * 32 + fr, fq * 8);
#define PG8_SA(b, h) (((b) * 2 + (h)) * HTB)
#define PG8_SB(b, h) ((4 + (b) * 2 + (h)) * HTB)
#define PG8_STAGE(bufoff, gbase, voff) do { _Pragma("unroll") for (int _i = 0; _i < 2; ++_i) \
        __builtin_amdgcn_global_load_lds((const unsigned*)((const char*)(gbase) + (voff)[_i]), (LAS unsigned*)(lds + (bufoff) + ldsw + _i * 8192), 16, 0, 0); } while (0)
#define PG8_LDA(dst, b, h) do { _Pragma("unroll") for (int m = 0; m < 4; ++m) _Pragma("unroll") for (int k = 0; k < 2; ++k) dst[m][k] = *(const LAS h8*)(lds + PG8_SA(b, h) + aoff + m * 2048 + k * 1024); } while (0)
#define PG8_LDB(dst, b, h) do { _Pragma("unroll") for (int n = 0; n < 2; ++n) _Pragma("unroll") for (int k = 0; k < 2; ++k) dst[n][k] = *(const LAS h8*)(lds + PG8_SB(b, h) + boff + n * 2048 + k * 1024); } while (0)
#define PG8_MMA(ai, bj, At, Bt) do { __builtin_amdgcn_s_setprio(1); _Pragma("unroll") for (int m = 0; m < 4; ++m) _Pragma("unroll") for (int n = 0; n < 2; ++n) _Pragma("unroll") for (int k = 0; k < 2; ++k) \
        acc[ai][bj][m][n] = __builtin_amdgcn_mfma_f32_16x16x32_f16(Bt[n][k], At[m][k], acc[ai][bj][m][n], 0, 0, 0); __builtin_amdgcn_s_setprio(0); } while (0)
#define PG8_WAIT_V(n) asm volatile("s_waitcnt vmcnt(" #n ")" ::: "memory")
#define PG8_WAIT_L(n) asm volatile("s_waitcnt lgkmcnt(" #n ")" ::: "memory")
#define PG8_BAR __builtin_amdgcn_s_barrier()
#define PG8_SCHED __builtin_amdgcn_sched_barrier(0)
    Unit cur, nxt; int ui = 0;
    if (!S.next(0, cur)) return;
    f32x4 acc[2][2][4][2];
#pragma unroll
    for (int a = 0; a < 2; ++a)
#pragma unroll
        for (int b = 0; b < 2; ++b)
#pragma unroll
            for (int m = 0; m < 4; ++m)
#pragma unroll
                for (int n = 0; n < 2; ++n) acc[a][b][m][n] = (f32x4){0.f, 0.f, 0.f, 0.f};
    h8 At[4][2], B0[2][2], B1[2][2];
    const char* cA = (const char*)g.A + (size_t)cur.pm * tstep; const char* cB = (const char*)g.Bt + (size_t)cur.pn * tstep;
    PG8_STAGE(PG8_SB(0, 0), cB, voffB); PG8_STAGE(PG8_SB(0, 1), cB + hstep, voffB); PG8_STAGE(PG8_SA(0, 0), cA, voffA); PG8_STAGE(PG8_SA(0, 1), cA + hstep, voffA);
    if (wr == 1) PG8_BAR;
    PG8_WAIT_V(2); PG8_BAR;
    PG8_STAGE(PG8_SB(1, 0), cB + kstep, voffB); PG8_STAGE(PG8_SA(1, 0), cA + kstep, voffA); PG8_STAGE(PG8_SB(1, 1), cB + hstep + kstep, voffB);
    PG8_WAIT_V(6); PG8_BAR;
    for (;;) {
        const bool has_next = S.next(ui + 1, nxt);
        const char* nA = has_next ? (const char*)g.A + (size_t)nxt.pm * tstep : cA; const char* nB = has_next ? (const char*)g.Bt + (size_t)nxt.pn * tstep : cB;
        for (int t = 0; t < nt; t += 2) {
            const bool last = (t == nt - 2);
            const char* a1 = cA + (size_t)(t + 1) * kstep;
            const char* a2 = last ? nA : cA + (size_t)(t + 2) * kstep; const char* b2 = last ? nB : cB + (size_t)(t + 2) * kstep;
            const char* a3 = a2 + kstep; const char* b3 = b2 + kstep;
            PG8_LDB(B0, 0, 0); PG8_LDB(B1, 0, 1); PG8_SCHED; PG8_LDA(At, 0, 0); PG8_STAGE(PG8_SA(1, 1), a1 + hstep, voffA);
            PG8_WAIT_V(8); PG8_WAIT_L(0); PG8_BAR; PG8_MMA(0, 0, At, B0); PG8_MMA(0, 1, At, B1); PG8_BAR; PG8_SCHED;
            PG8_LDA(At, 0, 1); PG8_STAGE(PG8_SB(0, 0), b2, voffB); PG8_STAGE(PG8_SB(0, 1), b2 + hstep, voffB); PG8_STAGE(PG8_SA(0, 0), a2, voffA);
            PG8_WAIT_V(8); PG8_WAIT_L(0); PG8_BAR; PG8_MMA(1, 0, At, B0); PG8_MMA(1, 1, At, B1); PG8_BAR; PG8_SCHED;
            PG8_LDB(B0, 1, 0); PG8_LDB(B1, 1, 1); PG8_SCHED; PG8_LDA(At, 1, 0); PG8_STAGE(PG8_SA(0, 1), a2 + hstep, voffA);
            PG8_WAIT_V(8); PG8_WAIT_L(0); PG8_BAR; PG8_MMA(0, 0, At, B0); PG8_MMA(0, 1, At, B1); PG8_BAR; PG8_SCHED;
            PG8_LDA(At, 1, 1); PG8_STAGE(PG8_SB(1, 0), b3, voffB); PG8_STAGE(PG8_SB(1, 1), b3 + hstep, voffB); PG8_STAGE(PG8_SA(1, 0), a3, voffA);
            PG8_WAIT_V(8); PG8_WAIT_L(0); PG8_BAR; PG8_MMA(1, 0, At, B0); PG8_MMA(1, 1, At, B1); PG8_BAR; PG8_SCHED;
        }
        if (wr == 0) PG8_BAR;
        E(acc, cur, wr, wc, fr, fq);
        if (wr == 1) PG8_BAR;
        if (!has_next) break;
#pragma unroll
        for (int a = 0; a < 2; ++a)
#pragma unroll
            for (int b = 0; b < 2; ++b)
#pragma unroll
                for (int m = 0; m < 4; ++m)
#pragma unroll
                    for (int n = 0; n < 2; ++n) acc[a][b][m][n] = (f32x4){0.f, 0.f, 0.f, 0.f};
        cur = nxt; cA = nA; cB = nB; ++ui;
    }
    PG8_WAIT_V(0);
    if (wr == 0) PG8_BAR;
    PG8_BAR;
#undef PG8_SA
#undef PG8_SB
#undef PG8_STAGE
#undef PG8_LDA
#undef PG8_LDB
#undef PG8_MMA
#undef PG8_WAIT_V
#undef PG8_WAIT_L
#undef PG8_BAR
#undef PG8_SCHED
}
}

__device__ __forceinline__ void transpose_tile(LAS float* tile, const float* __restrict__ src, int N, int k0, int n0, half_t* __restrict__ dst, int ldd, int drow0) {
    const int tid = threadIdx.x;
#pragma unroll
    for (int i = 0; i < 8; ++i) { const int kk = i * 8 + (tid >> 6), nn = tid & 63; tile[kk * 65 + nn] = src[(size_t)(k0 + kk) * N + n0 + nn]; }
    __syncthreads();
    { const int n = tid >> 3, kq = tid & 7; float v[8];
#pragma unroll
        for (int j = 0; j < 8; ++j) v[j] = tile[(kq * 8 + j) * 65 + n];
        u32x4 w; w.x = pk2h(v[0], v[1]); w.y = pk2h(v[2], v[3]); w.z = pk2h(v[4], v[5]); w.w = pk2h(v[6], v[7]);
        *(u32x4*)(dst + (size_t)(drow0 + n) * ldd + k0 + kq * 8) = w; }
    __syncthreads();
}

__device__ __forceinline__ void ln_row_to_f16(const float* __restrict__ xrow, const float* __restrict__ g, const float* __restrict__ b, half_t* __restrict__ orow, int lane) {
    f32x4 v[4]; float s = 0.f;
#pragma unroll
    for (int j = 0; j < 4; ++j) { v[j] = *(const f32x4*)(xrow + j * 256 + lane * 4); s += (v[j][0] + v[j][1]) + (v[j][2] + v[j][3]); }
    const float mu = wave_sum(s) * (1.0f / 1024.0f); float q = 0.f;
#pragma unroll
    for (int j = 0; j < 4; ++j) { v[j] = v[j] - mu; q += (v[j][0] * v[j][0] + v[j][1] * v[j][1]) + (v[j][2] * v[j][2] + v[j][3] * v[j][3]); }
    const float rstd = __builtin_amdgcn_rsqf(wave_sum(q) * (1.0f / 1024.0f) + LN_EPS);
#pragma unroll
    for (int j = 0; j < 4; ++j) { const f32x4 gg = *(const f32x4*)(g + j * 256 + lane * 4), bb = *(const f32x4*)(b + j * 256 + lane * 4); const f32x4 o = v[j] * rstd * gg + bb;
        u32x2 w; w.x = pk2h(o[0], o[1]); w.y = pk2h(o[2], o[3]); *(u32x2*)(orow + j * 256 + lane * 4) = w; }
}

__device__ void phase_prologue(LAS unsigned char* lds, const Params& P) {
    unsigned char* ws = P.ws;
    const int tid = threadIdx.x, G = gridDim.x, bx = blockIdx.x;
    LAS float* tile = (LAS float*)lds;
    const int T0 = 16 * 28, T1 = T0 + 16 * 16, T2 = T1 + 16 * 44, T3 = T2 + 16 * 44, T4 = T3 + 44 * 16, T5 = T4 + 16 * 16, T6 = T5 + 4 * 16;
    for (int t = bx; t < T0; t += G) {
        const float* src; int N, loc, ldd, kind = 0, ncols = 0; half_t* dst;
        if (t < T0) { src = P.in[4]; N = NIN; ncols = 1792; loc = t; dst = (half_t*)(ws + WS_WIN); ldd = DM; }
        else if (t < T1) { src = P.in[18]; N = DM; loc = t - T0; dst = (half_t*)(ws + WS_WOUT); ldd = DM; }
        else if (t < T2) { src = P.in[21]; N = DFF; loc = t - T1; dst = (half_t*)(ws + WS_WGU); ldd = DM; kind = 1; }
        else if (t < T3) { src = P.in[22]; N = DFF; loc = t - T2; dst = (half_t*)(ws + WS_WGU); ldd = DM; kind = 2; }
        else if (t < T4) { src = P.in[23]; N = DM; loc = t - T3; dst = (half_t*)(ws + WS_WDN); ldd = DFF; }
        else if (t < T5) { src = P.in[25]; N = DM; loc = t - T4; dst = (half_t*)(ws + WS_WPLG); ldd = DM; }
        else { src = P.in[24]; N = DM; loc = t - T5; dst = (half_t*)(ws + WS_WPLP); ldd = DPLE; }
        const int ntn = (ncols ? ncols : N) / 64, kt = loc / ntn, nt_ = loc % ntn, n0 = nt_ * 64;
        int drow0 = n0;
        if (kind) drow0 = (n0 >> 7) * 256 + (n0 & 127) + (kind == 2 ? 128 : 0);
        transpose_tile(tile, src, N, kt * 64, n0, dst, ldd, drow0);
    }
    const int gtid = bx * NTHREADS + tid, gth = G * NTHREADS;
    { half_t* wl = (half_t*)(ws + WS_WLORA);
        for (int i = gtid; i < 1536 * 256; i += gth) { const int n = i >> 8, k = i & 255; float v = 0.f;
            if (n < 512) { if (k < 64) v = P.in[7][k * 512 + n]; }
            else if (n < 1024) { if (k >= 64 && k < 128) v = P.in[9][(k - 64) * 512 + (n - 512)]; }
            else { if (k >= 128) v = P.in[10][(k - 128) * 512 + (n - 1024)]; }
            wl[i] = (half_t)v; } }
    { half_t* wt_in = (half_t*)(ws + WS_WIN); LAS float* Pw = (LAS float*)lds; LAS float* Wl = (LAS float*)(lds + 65536);
        for (int job = bx; job < 256; job += G) {
            const int g = job >> 6, k0 = (job & 63) * 16;
            __syncthreads();
            for (int i = tid; i < 4096; i += NTHREADS) *(LAS f32x4*)(Pw + i * 4) = *(const f32x4*)(P.in[16] + (size_t)g * 16384 + i * 4);
            { const int r = tid >> 5, c4 = (tid & 31) * 4; *(LAS f32x4*)(Wl + r * 128 + c4) = *(const f32x4*)(P.in[4] + (size_t)(k0 + r) * NIN + 1792 + g * 128 + c4); }
            __syncthreads();
            const int d = tid & 127, kr = tid >> 7; float acc[4] = {0.f, 0.f, 0.f, 0.f};
#pragma unroll 4
            for (int c = 0; c < 128; c += 4) {
                const float p0 = Pw[c * 128 + d], p1 = Pw[(c + 1) * 128 + d], p2 = Pw[(c + 2) * 128 + d], p3 = Pw[(c + 3) * 128 + d];
#pragma unroll
                for (int j = 0; j < 4; ++j) { const f32x4 wv = *(const LAS f32x4*)(Wl + (kr * 4 + j) * 128 + c); acc[j] += wv[0] * p0 + wv[1] * p1 + wv[2] * p2 + wv[3] * p3; } }
            u32x2 w; w.x = pk2h(acc[0], acc[1]); w.y = pk2h(acc[2], acc[3]);
            *(u32x2*)(wt_in + (size_t)(1792 + g * 128 + d) * DM + k0 + kr * 4) = w;
        }
        __syncthreads(); }
    { const int lane = tid & 63, wv = tid >> 6; half_t* h0 = (half_t*)(ws + WS_H0);
        f32x4 gg[4], bb[4];
#pragma unroll
        for (int j = 0; j < 4; ++j) { gg[j] = *(const f32x4*)(P.in[2] + j * 256 + lane * 4); bb[j] = *(const f32x4*)(P.in[3] + j * 256 + lane * 4); }
        for (int row = (bx * 8 + wv) * 2; row < MTOK; row += G * 16) {
            f32x4 v[2][4];
#pragma unroll
            for (int r = 0; r < 2; ++r)
#pragma unroll
                for (int j = 0; j < 4; ++j) v[r][j] = __builtin_nontemporal_load((const f32x4*)(P.in[0] + (size_t)(row + r) * DM + j * 256 + lane * 4));
#pragma unroll
            for (int r = 0; r < 2; ++r) {
                float s_ = 0.f;
#pragma unroll
                for (int j = 0; j < 4; ++j) s_ += (v[r][j][0] + v[r][j][1]) + (v[r][j][2] + v[r][j][3]);
                const float mu = wave_sum(s_) * (1.0f / 1024.0f); float q = 0.f;
#pragma unroll
                for (int j = 0; j < 4; ++j) { v[r][j] = v[r][j] - mu; q += (v[r][j][0] * v[r][j][0] + v[r][j][1] * v[r][j][1]) + (v[r][j][2] * v[r][j][2] + v[r][j][3] * v[r][j][3]); }
                const float rstd = __builtin_amdgcn_rsqf(wave_sum(q) * (1.0f / 1024.0f) + LN_EPS);
#pragma unroll
                for (int j = 0; j < 4; ++j) { const f32x4 o = v[r][j] * rstd * gg[j] + bb[j]; u32x2 w; w.x = pk2h(o[0], o[1]); w.y = pk2h(o[2], o[3]); *(u32x2*)(h0 + (size_t)(row + r) * DM + j * 256 + lane * 4) = w; }
            }
        }
    }
}

template <int W> __device__ __forceinline__ void pool_group(const half_t* __restrict__ Z, half_t* __restrict__ Y, const float* __restrict__ scale, int g, int gtid, int gth) {
    for (int i = gtid; i < MTOK * 16; i += gth) {
        const int m = i >> 4, jc = g * 16 + (i & 15), t = m & (SEQ - 1);
        const half_t* zp = Z + (size_t)m * NIN + 1792 + jc * 8;
        h8 u[W];
#pragma unroll
        for (int q = 0; q < W; ++q) { if (q <= t) u[q] = *(const h8*)(zp - (size_t)q * NIN); else u[q] = (h8){0, 0, 0, 0, 0, 0, 0, 0}; }
        const int cnt = (t + 1) < W ? (t + 1) : W; const float inv = 1.0f / (float)cnt; float r[8];
#pragma unroll
        for (int e = 0; e < 8; ++e) { float s = 0.f;
#pragma unroll
            for (int q = 0; q < W; ++q) s += (float)u[q][e];
            r[e] = (s * inv - (float)u[0][e]) * scale[jc * 8 + e]; }
        u32x4 w; w.x = pk2h(r[0], r[1]); w.y = pk2h(r[2], r[3]); w.z = pk2h(r[4], r[5]); w.w = pk2h(r[6], r[7]);
        *(u32x4*)(Y + (size_t)m * DM + 512 + jc * 8) = w;
    }
}
__device__ void phase_prep(const Params& P) {
    unsigned char* ws = P.ws;
    const half_t* Z = (const half_t*)(ws + WS_Z); half_t* AL = (half_t*)(ws + WS_AL); half_t* Yb = (half_t*)(ws + WS_Y);
    const float* mu = P.in[5];
    const int gtid = blockIdx.x * NTHREADS + threadIdx.x, gth = gridDim.x * NTHREADS;
    for (int i = gtid; i < MTOK * 32; i += gth) {
        const int m = i >> 5, j = i & 31, t = m & (SEQ - 1);
        const half_t* zrow = Z + (size_t)m * NIN;
        const int cz = 1536 + j * 8;
        const h8 zc = *(const h8*)(zrow + cz); h8 zp;
        if (t > 0) zp = *(const h8*)(zrow - NIN + cz); else zp = (h8){0, 0, 0, 0, 0, 0, 0, 0};
        const f32x4 m0 = *(const f32x4*)(mu + cz), m1 = *(const f32x4*)(mu + cz + 4); float r[8];
#pragma unroll
        for (int e = 0; e < 8; ++e) { const float zz = (float)zc[e], mm = e < 4 ? m0[e & 3] : m1[e & 3]; float v = zz + ((float)zp[e] - zz) * mm;
            if (j < 8) { const float tt = __builtin_amdgcn_exp2f(2.88539008f * v); v = 1.0f - 2.0f * __builtin_amdgcn_rcpf(1.0f + tt); }
            else if (j >= 16) v = sigm(v);
            r[e] = v; }
        u32x4 w; w.x = pk2h(r[0], r[1]); w.y = pk2h(r[2], r[3]); w.z = pk2h(r[4], r[5]); w.w = pk2h(r[6], r[7]);
        *(u32x4*)(AL + (size_t)m * 256 + j * 8) = w;
    }
    pool_group<2>(Z, Yb, P.in[17], 0, gtid, gth);
    pool_group<4>(Z, Yb, P.in[17], 1, gtid, gth);
    pool_group<8>(Z, Yb, P.in[17], 2, gtid, gth);
    pool_group<16>(Z, Yb, P.in[17], 3, gtid, gth);
}

constexpr int TC = 32;
constexpr int STEPF = 384;
constexpr int SC_BUF = 0, SC_SCAL = 2 * TC * STEPF * 4, SC_YB = SC_SCAL + 2 * TC * 4 * 4, SC_VR = SC_YB + 4 * 32 * 33 * 4, SC_BR = SC_VR + 4 * TC * 32 * 2, SC_CST = SC_BR + 4 * TC * 8, SC_END = SC_CST + 8 * 64 * 4;
static_assert(SC_END <= LDS_BYTES, "scan lds");

__device__ __forceinline__ float wave_sum_dpp(float v) {
    v = red16(v);
    v += __int_as_float(__builtin_amdgcn_update_dpp(0, __float_as_int(v), 0x142, 0xA, 0xF, false));
    v += __int_as_float(__builtin_amdgcn_update_dpp(0, __float_as_int(v), 0x143, 0xC, 0xF, false));
    return __int_as_float(__builtin_amdgcn_readlane(__float_as_int(v), 63));
}

struct ScanRaw { h8 zr, zk, zv, pr, pk, pv, lw, la; };
struct ScanStep { f32x4 kkA, kkB, wrA, wrB, wA, wB, k2A, k2B, bnA, bnB; float vv; };

__device__ __forceinline__ void scan_load_raw(ScanRaw& R, const half_t* __restrict__ Z, const half_t* __restrict__ LO, size_t mb, int t, int hc8) {
    const half_t* zp = Z + (mb + t) * NIN + hc8; const half_t* lp = LO + (mb + t) * 1536 + hc8;
    R.zr = *(const h8*)(zp); R.zk = *(const h8*)(zp + 512); R.zv = *(const h8*)(zp + 1024); R.lw = *(const h8*)(lp); R.la = *(const h8*)(lp + 512);
    if (t > 0) { R.pr = *(const h8*)(zp - NIN); R.pk = *(const h8*)(zp - NIN + 512); R.pv = *(const h8*)(zp - NIN + 1024); }
    else { R.pr = (h8){0, 0, 0, 0, 0, 0, 0, 0}; R.pk = R.pr; R.pv = R.pr; }
}

#define SCAN_BAR() do { asm volatile("s_waitcnt lgkmcnt(0)" ::: "memory"); __builtin_amdgcn_s_barrier(); asm volatile("" ::: "memory"); } while (0)
__device__ void phase_scan(LAS unsigned char* lds, const Params& P) {
    unsigned char* ws = P.ws;
    const half_t* Z = (const half_t*)(ws + WS_Z); const half_t* LO = (const half_t*)(ws + WS_LO);
    unsigned long long* XS = (unsigned long long*)(ws + WS_XS); half_t* Y = (half_t*)(ws + WS_Y);
    const int tid = threadIdx.x, lane = tid & 63, wave = __builtin_amdgcn_readfirstlane(tid >> 6);
    LAS float* bufs = (LAS float*)(lds + SC_BUF); LAS float* scal = (LAS float*)(lds + SC_SCAL); LAS float* ybs = (LAS float*)(lds + SC_YB);
    LAS half_t* vring = (LAS half_t*)(lds + SC_VR); LAS float* bring = (LAS float*)(lds + SC_BR);
    for (int item = blockIdx.x; item < 256; item += gridDim.x) {
        const int half = item & 1, bh = item >> 1, h = bh & 7, b = bh >> 3;
        const size_t mb = (size_t)b * SEQ;
        LAS float* cst = (LAS float*)(lds + SC_CST);
        if (tid < 64) { const int hc = h * 64 + tid; cst[tid] = P.in[5][hc]; cst[64 + tid] = P.in[5][512 + hc]; cst[128 + tid] = P.in[5][1024 + hc]; cst[192 + tid] = P.in[6][hc];
            cst[256 + tid] = P.in[8][hc]; cst[320 + tid] = P.in[11][hc]; cst[384 + tid] = P.in[12][hc]; cst[448 + tid] = P.in[13][hc]; }
        __syncthreads();
        if (wave >= 4) {
            const int pw = wave - 4, s8 = lane >> 3, cg = lane & 7, hc8 = h * 64 + cg * 8, tt = pw * 8 + s8;
            const int ptid = tid - 256, ft = ptid >> 3, q = ptid & 7, oc = h * 64 + half * 32 + q * 4;
            const f32x4 lng = *(const f32x4*)(P.in[14] + oc), lnb = *(const f32x4*)(P.in[15] + oc);
            unsigned long long* xs_mine = XS + ((size_t)(bh * 2 + half)) * SEQ; const unsigned long long* xs_peer = XS + ((size_t)(bh * 2 + (half ^ 1))) * SEQ;
#define SCAN_Y4(fc) (f32x4){ybs[((fc) & 3) * (32 * 33) + (q * 4 + 0) * 33 + ft], ybs[((fc) & 3) * (32 * 33) + (q * 4 + 1) * 33 + ft], ybs[((fc) & 3) * (32 * 33) + (q * 4 + 2) * 33 + ft], ybs[((fc) & 3) * (32 * 33) + (q * 4 + 3) * 33 + ft]}
#define SCAN_PUBLISH(fc) do { f32x4 y4 = SCAN_Y4(fc); { const h4 vq_ = *(const LAS h4*)(vring + (((fc) & 3) * TC + ft) * 32 + q * 4); const float kr_ = bring[(((fc) & 3) * TC + ft) * 2 + 1]; \
                y4[0] += (float)vq_[0] * kr_; y4[1] += (float)vq_[1] * kr_; y4[2] += (float)vq_[2] * kr_; y4[3] += (float)vq_[3] * kr_; }     \
                float s1 = (y4[0] + y4[1]) + (y4[2] + y4[3]), s2 = (y4[0] * y4[0] + y4[1] * y4[1]) + (y4[2] * y4[2] + y4[3] * y4[3]); \
                s1 = red8(s1); s2 = red8(s2) + 1e-30f; \
                if (q == 0) __hip_atomic_store(xs_mine + (fc) * TC + ft, ((unsigned long long)__float_as_uint(s2) << 32) | __float_as_uint(s1), __ATOMIC_RELAXED, __HIP_MEMORY_SCOPE_AGENT); } while (0)
#define SCAN_FINAL_LOAD(fz, G4, PW) do { const int t_ = (fz) * TC + ft; G4 = *(const h4*)(LO + (mb + t_) * 1536 + 1024 + oc); PW = __hip_atomic_load(xs_peer + t_, __ATOMIC_RELAXED, __HIP_MEMORY_SCOPE_AGENT); } while (0)
#define SCAN_FINAL(fz, G4, PW) do { const int t_ = (fz) * TC + ft; f32x4 y4 = SCAN_Y4(fz); \
                const h4 v4 = *(const LAS h4*)(vring + (((fz) & 3) * TC + ft) * 32 + q * 4); const f32x2 bk_ = *(const LAS f32x2*)(bring + (((fz) & 3) * TC + ft) * 2); const float bon_ = bk_[0]; \
                y4[0] += (float)v4[0] * bk_[1]; y4[1] += (float)v4[1] * bk_[1]; y4[2] += (float)v4[2] * bk_[1]; y4[3] += (float)v4[3] * bk_[1]; \
                const h4 g4 = G4; unsigned long long pw_ = PW; \
                { unsigned sp_ = 0; while (pw_ == 0ull && ++sp_ < (1u << 22)) { __builtin_amdgcn_s_sleep(1); pw_ = __hip_atomic_load(xs_peer + t_, __ATOMIC_RELAXED, __HIP_MEMORY_SCOPE_AGENT); } } \
                float s1 = (y4[0] + y4[1]) + (y4[2] + y4[3]), s2 = (y4[0] * y4[0] + y4[1] * y4[1]) + (y4[2] * y4[2] + y4[3] * y4[3]); \
                s1 = red8(s1) + __uint_as_float((unsigned)pw_); s2 = red8(s2) + __uint_as_float((unsigned)(pw_ >> 32)); \
                const float mean = s1 * (1.0f / 64.0f), var = fmaxf(s2 * (1.0f / 64.0f) - mean * mean, 0.f), rstd = __builtin_amdgcn_rsqf(var + GN_EPS); \
                float o_[4]; \
                _Pragma("unroll") for (int j = 0; j < 4; ++j) o_[j] = ((y4[j] - mean) * rstd * lng[j] + lnb[j] + bon_ * (float)v4[j]) * (float)g4[j]; \
                u32x2 w2_; w2_.x = pk2h(o_[0], o_[1]); w2_.y = pk2h(o_[2], o_[3]); *(u32x2*)(Y + (mb + t_) * DM + oc) = w2_; } while (0)
            ScanRaw Ra, Rb;
            scan_load_raw(Ra, Z, LO, mb, tt, hc8);
#define SCAN_PROD_ITER(ch, CUR, NXT) do { \
                const int pc_ = (ch) + 1; \
                h4 fg4_ = (h4){0, 0, 0, 0}; unsigned long long fpw_ = 0ull; if ((ch) >= 2) SCAN_FINAL_LOAD((ch) - 2, fg4_, fpw_);     \
                  \
                float wv_[8]; half_t* wdst_ = nullptr; f32x4 pv_; const bool pdo_ = (pc_ < 64) && (ptid < 128); \
                if (pc_ < 64 && ptid < 84) { int it_ = item * 5376 + pc_ * 84 + ptid; const float* src_; half_t* db_; int N_, ldd_, kind_ = 0; \
                    if (it_ < 131072) { src_ = P.in[18]; db_ = (half_t*)(ws + WS_WOUT); N_ = DM; ldd_ = DM; } \
                    else if ((it_ -= 131072) < 360448) { src_ = P.in[21]; db_ = (half_t*)(ws + WS_WGU); N_ = DFF; ldd_ = DM; kind_ = 1; } \
                    else if ((it_ -= 360448) < 360448) { src_ = P.in[22]; db_ = (half_t*)(ws + WS_WGU); N_ = DFF; ldd_ = DM; kind_ = 2; } \
                    else if ((it_ -= 360448) < 360448) { src_ = P.in[23]; db_ = (half_t*)(ws + WS_WDN); N_ = DM; ldd_ = DFF; } \
                    else if ((it_ -= 360448) < 131072) { src_ = P.in[25]; db_ = (half_t*)(ws + WS_WPLG); N_ = DM; ldd_ = DM; } \
                    else { it_ -= 131072; src_ = P.in[24]; db_ = (half_t*)(ws + WS_WPLP); N_ = DM; ldd_ = DPLE; } \
                    const int kg_ = it_ / N_, n_ = it_ - kg_ * N_; \
                    const int row_ = kind_ ? ((n_ >> 7) * 256 + (n_ & 127) + (kind_ == 2 ? 128 : 0)) : n_; \
                    const float* sp_ = src_ + (size_t)(kg_ * 8) * N_ + n_; \
                    _Pragma("unroll") for (int e = 0; e < 8; ++e) wv_[e] = sp_[(size_t)e * N_]; \
                    wdst_ = db_ + (size_t)row_ * ldd_ + kg_ * 8; } \
                if (pdo_) pv_ = ((const f32x4*)P.in[1])[item * 8192 + pc_ * 128 + ptid]; \
                if (pc_ + 1 < 64) scan_load_raw(NXT, Z, LO, mb, (pc_ + 1) * TC + tt, hc8); \
                if (pc_ < 64) { \
                    LAS float* dst = bufs + (pc_ & 1) * (TC * STEPF) + tt * STEPF + cg * 8; LAS float* dsc = scal + (pc_ & 1) * (TC * 4); \
                    float kk[8], wr_[8], w_[8], k2[8], bn[8], vv_[8]; float ss = 0.f, brs = 0.f, krs = 0.f, bons = 0.f; \
                    float mu_r[8], mu_k[8], mu_v[8], w0c[8], a0c[8], kkc[8], kac[8], rkc[8]; \
                    _Pragma("unroll") for (int hf = 0; hf < 2; ++hf) { const LAS float* cp = cst + cg * 8 + hf * 4; \
                        const f32x4 c0 = *(const LAS f32x4*)(cp), c1 = *(const LAS f32x4*)(cp + 64), c2 = *(const LAS f32x4*)(cp + 128), c3 = *(const LAS f32x4*)(cp + 192), \
                                    c4 = *(const LAS f32x4*)(cp + 256), c5 = *(const LAS f32x4*)(cp + 320), c6 = *(const LAS f32x4*)(cp + 384), c7 = *(const LAS f32x4*)(cp + 448); \
                        _Pragma("unroll") for (int j = 0; j < 4; ++j) { mu_r[hf * 4 + j] = c0[j]; mu_k[hf * 4 + j] = c1[j]; mu_v[hf * 4 + j] = c2[j]; w0c[hf * 4 + j] = c3[j]; a0c[hf * 4 + j] = c4[j]; kkc[hf * 4 + j] = c5[j]; kac[hf * 4 + j] = c6[j]; rkc[hf * 4 + j] = c7[j]; } } \
                    _Pragma("unroll") for (int e = 0; e < 8; ++e) { \
                        const float r0 = (float)CUR.zr[e], k0 = (float)CUR.zk[e], v0 = (float)CUR.zv[e]; \
                        const float r = r0 + ((float)CUR.pr[e] - r0) * mu_r[e], k = k0 + ((float)CUR.pk[e] - k0) * mu_k[e]; vv_[e] = v0 + ((float)CUR.pv[e] - v0) * mu_v[e]; \
                        const float sg = sigm(w0c[e] + (float)CUR.lw[e]); \
                        const float w = __builtin_amdgcn_exp2f(-0.875057039f * sg); \
                        const float a = sigm(a0c[e] + (float)CUR.la[e]); \
                        const float kq = k * kkc[e]; ss += kq * kq; kk[e] = kq; \
                        k2[e] = k * (1.0f + (a - 1.0f) * kac[e]); \
                        bn[e] = -kq * a; brs += bn[e] * r; \
                        const float pr = k2[e] * r; krs += pr; bons += pr * rkc[e]; \
                        w_[e] = w; wr_[e] = w * r; } \
                    ss = red8(ss); brs = red8(brs); krs = red8(krs); bons = red8(bons); \
                    const float rn = __builtin_amdgcn_rsqf(fmaxf(ss, 1e-24f)); brs *= rn; \
                    _Pragma("unroll") for (int e = 0; e < 8; ++e) { kk[e] *= rn; bn[e] *= rn; wr_[e] += brs * kk[e]; }     \
                    *(LAS f32x4*)(dst) = (f32x4){kk[0], kk[1], kk[2], kk[3]}; *(LAS f32x4*)(dst + 4) = (f32x4){kk[4], kk[5], kk[6], kk[7]}; \
                    *(LAS f32x4*)(dst + 64) = (f32x4){wr_[0], wr_[1], wr_[2], wr_[3]}; *(LAS f32x4*)(dst + 68) = (f32x4){wr_[4], wr_[5], wr_[6], wr_[7]}; \
                    *(LAS f32x4*)(dst + 128) = (f32x4){w_[0], w_[1], w_[2], w_[3]}; *(LAS f32x4*)(dst + 132) = (f32x4){w_[4], w_[5], w_[6], w_[7]}; \
                    *(LAS f32x4*)(dst + 192) = (f32x4){k2[0], k2[1], k2[2], k2[3]}; *(LAS f32x4*)(dst + 196) = (f32x4){k2[4], k2[5], k2[6], k2[7]}; \
                    *(LAS f32x4*)(dst + 256) = (f32x4){bn[0], bn[1], bn[2], bn[3]}; *(LAS f32x4*)(dst + 260) = (f32x4){bn[4], bn[5], bn[6], bn[7]}; \
                    *(LAS f32x4*)(dst + 320) = (f32x4){vv_[0], vv_[1], vv_[2], vv_[3]}; *(LAS f32x4*)(dst + 324) = (f32x4){vv_[4], vv_[5], vv_[6], vv_[7]}; \
                    if (cg == 0) *(LAS f32x2*)(bring + ((pc_ & 3) * TC + tt) * 2) = (f32x2){bons, krs}; \
                    if ((cg >> 2) == half) { u32x4 vw_; vw_.x = pk2h(vv_[0], vv_[1]); vw_.y = pk2h(vv_[2], vv_[3]); vw_.z = pk2h(vv_[4], vv_[5]); vw_.w = pk2h(vv_[6], vv_[7]); \
                        *(LAS u32x4*)(vring + ((pc_ & 3) * TC + tt) * 32 + (cg & 3) * 8) = vw_; } \
                } \
                if ((ch) >= 1) SCAN_PUBLISH((ch) - 1); \
                if ((ch) >= 2) SCAN_FINAL((ch) - 2, fg4_, fpw_); \
                if (wdst_) { u32x4 ww_; ww_.x = pk2h(wv_[0], wv_[1]); ww_.y = pk2h(wv_[2], wv_[3]); ww_.z = pk2h(wv_[4], wv_[5]); ww_.w = pk2h(wv_[6], wv_[7]); *(u32x4*)wdst_ = ww_; } \
                if (pdo_) { u32x2 pw2_; pw2_.x = pk2h(pv_[0], pv_[1]); pw2_.y = pk2h(pv_[2], pv_[3]); ((u32x2*)(ws + WS_P16))[item * 8192 + pc_ * 128 + ptid] = pw2_; } \
                __syncthreads(); \
            } while (0)
            for (int ch = -1; ch < 63; ch += 2) { SCAN_PROD_ITER(ch, Ra, Rb); SCAN_PROD_ITER(ch + 1, Rb, Ra); }
            SCAN_PROD_ITER(63, Ra, Rb);
#undef SCAN_PROD_ITER
            { h4 ga_, gb_; unsigned long long pa_, pb_; SCAN_FINAL_LOAD(62, ga_, pa_); SCAN_FINAL_LOAD(63, gb_, pb_); SCAN_PUBLISH(63); SCAN_FINAL(62, ga_, pa_); SCAN_FINAL(63, gb_, pb_); }
#undef SCAN_Y4
#undef SCAN_PUBLISH
#undef SCAN_FINAL
#undef SCAN_FINAL_LOAD
            __syncthreads();
        } else {
            const int row = wave * 8 + (lane >> 3), kl = lane & 7;
            f32x2 S0 = {0.f, 0.f}, S1 = {0.f, 0.f}, S2 = {0.f, 0.f}, S3 = {0.f, 0.f};
            __syncthreads();
            for (int ch = 0; ch < 64; ++ch) {
                const LAS float* src = bufs + (ch & 1) * (TC * STEPF); const LAS float* ssc = scal + (ch & 1) * (TC * 4); LAS float* yb = ybs + (ch & 3) * (32 * 33) + row * 33 + kl; float ykeep = 0.f;
                const LAS float* sbk = src + kl * 8; const LAS float* sbv = src + 320 + half * 32 + row;
#define SCAN_LOAD(Q, tt) do { const LAS float* sb = sbk + (tt) * STEPF; \
                    Q.kkA = *(const LAS f32x4*)(sb); Q.kkB = *(const LAS f32x4*)(sb + 4); Q.wrA = *(const LAS f32x4*)(sb + 64); Q.wrB = *(const LAS f32x4*)(sb + 68); \
                    Q.wA = *(const LAS f32x4*)(sb + 128); Q.wB = *(const LAS f32x4*)(sb + 132); Q.k2A = *(const LAS f32x4*)(sb + 192); Q.k2B = *(const LAS f32x4*)(sb + 196); \
                    Q.bnA = *(const LAS f32x4*)(sb + 256); Q.bnB = *(const LAS f32x4*)(sb + 260); Q.vv = sbv[(tt) * STEPF]; } while (0)
#define SCAN_COMPUTE(Q, tt) do { \
                    f32x2 pa2 = S0 * (f32x2){Q.kkA[0], Q.kkA[1]}; pa2 = S1 * (f32x2){Q.kkA[2], Q.kkA[3]} + pa2; pa2 = S2 * (f32x2){Q.kkB[0], Q.kkB[1]} + pa2; pa2 = S3 * (f32x2){Q.kkB[2], Q.kkB[3]} + pa2; \
                    f32x2 py2 = S0 * (f32x2){Q.wrA[0], Q.wrA[1]}; py2 = S1 * (f32x2){Q.wrA[2], Q.wrA[3]} + py2; py2 = S2 * (f32x2){Q.wrB[0], Q.wrB[1]} + py2; py2 = S3 * (f32x2){Q.wrB[2], Q.wrB[3]} + py2; \
                    float pa = pa2[0] + pa2[1], py = py2[0] + py2[1]; \
                    pa = red8(pa); py = red8(py); \
                    const f32x2 vv2 = {Q.vv, Q.vv}, pav = {pa, pa}; \
                    S0 = S0 * (f32x2){Q.wA[0], Q.wA[1]} + vv2 * (f32x2){Q.k2A[0], Q.k2A[1]}; S0 = pav * (f32x2){Q.bnA[0], Q.bnA[1]} + S0; \
                    S1 = S1 * (f32x2){Q.wA[2], Q.wA[3]} + vv2 * (f32x2){Q.k2A[2], Q.k2A[3]}; S1 = pav * (f32x2){Q.bnA[2], Q.bnA[3]} + S1; \
                    S2 = S2 * (f32x2){Q.wB[0], Q.wB[1]} + vv2 * (f32x2){Q.k2B[0], Q.k2B[1]}; S2 = pav * (f32x2){Q.bnB[0], Q.bnB[1]} + S2; \
                    S3 = S3 * (f32x2){Q.wB[2], Q.wB[3]} + vv2 * (f32x2){Q.k2B[2], Q.k2B[3]}; S3 = pav * (f32x2){Q.bnB[2], Q.bnB[3]} + S3; \
                    { const float y_ = py;                                     ykeep = (kl == ((tt) & 7)) ? y_ : ykeep;     \
                      if (((tt) & 7) == 7) yb[(tt) - 7] = ykeep; } \
                } while (0)
                ScanStep q0, q1, q2;
                SCAN_LOAD(q0, 0); SCAN_LOAD(q1, 1);
#pragma unroll
                for (int tt = 0; tt < TC; tt += 3) {
                    if (tt + 2 < TC) SCAN_LOAD(q2, tt + 2);
                    __builtin_amdgcn_sched_barrier(0);
                    SCAN_COMPUTE(q0, tt);
                    if (tt + 1 < TC) { if (tt + 3 < TC) SCAN_LOAD(q0, tt + 3); __builtin_amdgcn_sched_barrier(0); SCAN_COMPUTE(q1, tt + 1); }
                    if (tt + 2 < TC) { if (tt + 4 < TC) SCAN_LOAD(q1, tt + 4); __builtin_amdgcn_sched_barrier(0); SCAN_COMPUTE(q2, tt + 2); }
                }
#undef SCAN_LOAD
#undef SCAN_COMPUTE
                __syncthreads();
            }
            __syncthreads();
        }
    }
}

__device__ void phase_ln1(const Params& P) {
    half_t* H1 = (half_t*)(P.ws + WS_H1);
    const int lane = threadIdx.x & 63, wv = threadIdx.x >> 6;
    for (int row = blockIdx.x * 8 + wv; row < MTOK; row += gridDim.x * 8) ln_row_to_f16(P.out + (size_t)row * DM, P.in[19], P.in[20], H1 + (size_t)row * DM, lane);
}
__device__ void phase_ln2(const Params& P) {
    const int lane = threadIdx.x & 63, wv = threadIdx.x >> 6;
    const float* g = P.in[26]; const float* b = P.in[27];
    for (int row = blockIdx.x * 8 + wv; row < MTOK; row += gridDim.x * 8) {
        float* xrow = P.out + (size_t)row * DM;
        f32x4 v[4]; float s = 0.f;
#pragma unroll
        for (int j = 0; j < 4; ++j) { v[j] = *(const f32x4*)(xrow + j * 256 + lane * 4); s += (v[j][0] + v[j][1]) + (v[j][2] + v[j][3]); }
        const float mu = wave_sum(s) * (1.0f / 1024.0f); float q = 0.f;
#pragma unroll
        for (int j = 0; j < 4; ++j) { v[j] = v[j] - mu; q += (v[j][0] * v[j][0] + v[j][1] * v[j][1]) + (v[j][2] * v[j][2] + v[j][3] * v[j][3]); }
        const float rstd = __builtin_amdgcn_rsqf(wave_sum(q) * (1.0f / 1024.0f) + LN_EPS);
#pragma unroll
        for (int j = 0; j < 4; ++j) { const f32x4 gg = *(const f32x4*)(g + j * 256 + lane * 4), bb = *(const f32x4*)(b + j * 256 + lane * 4);
            *(f32x4*)(xrow + j * 256 + lane * 4) = v[j] * rstd * gg + bb; }
    }
}

__global__ void __launch_bounds__(NTHREADS) fwd_megakernel(Params P) {
    extern __shared__ __attribute__((aligned(16))) unsigned char lds_raw[];
    LAS unsigned char* lds = (LAS unsigned char*)lds_raw;
    cg::grid_group grid = cg::this_grid();
    if (P.ph_hi < 0) grid.sync();
    volatile LAS unsigned* xst = (volatile LAS unsigned*)(lds + LDS_BYTES);
    if (threadIdx.x < 2) xst[threadIdx.x] = 0u;
    __syncthreads();
    XcdBarrier xbar = xcd_barrier_post((unsigned*)P.ws, xst);
    unsigned char* ws = P.ws;
    const int lo = P.ph_lo, hi = P.ph_hi, G = gridDim.x, bx = blockIdx.x;
#define IN(k) (lo <= (k) && (k) < hi)
#define REP(k) for (int rep_ = 0; rep_ < (((PROBE_DUP >> (k)) & 1) ? 2 : 1); ++rep_)
#ifndef PROBE_SYNCS
#define PROBE_SYNCS 0
#endif
#define SEAM(k) do { if (IN(k) && IN((k) + 1)) { xcd_barrier(xbar); for (int s_ = 0; s_ < PROBE_SYNCS; ++s_) xcd_barrier(xbar); } } while (0)
    if (IN(0)) REP(0) { phase_prologue(lds, P); } SEAM(0);
    if (IN(1)) REP(1) {
        pg8::Gemm g{(const half_t*)(ws + WS_H0), (const half_t*)(ws + WS_WIN), MTOK, NIN, DM}; pg8::StaticOrder S; S.init(MTOK, NIN, G, bx);
        pg8::EpiH E{(half_t*)(ws + WS_Z), NIN, 0, nullptr};
        pg8::gemm_phase<pg8::EpiH>(lds, g, S, E);
    } SEAM(1);
    if (IN(2)) REP(2) { phase_prep(P); } SEAM(2);
    if (IN(3)) REP(3) {
        { pg8::Gemm g{(const half_t*)(ws + WS_AL), (const half_t*)(ws + WS_WLORA), MTOK, 1536, 256}; pg8::StaticOrder S; S.init(MTOK, 1536, G, bx);
            pg8::EpiH E{(half_t*)(ws + WS_LO), 1536, 0, nullptr};
            pg8::gemm_phase<pg8::EpiH>(lds, g, S, E); }
    } SEAM(3);
    if (IN(4)) REP(4) { phase_scan(lds, P); } SEAM(4);
    LAS unsigned char* tl = lds + LDS_TAB;
    if (IN(6)) REP(6) {
        pg8::Gemm g{(const half_t*)(ws + WS_Y), (const half_t*)(ws + WS_WOUT), MTOK, DM, DM}; pg8::StaticOrder S; S.init(MTOK, DM, G, bx);
        pg8::PanelStats st{(unsigned long long*)(ws + WS_XB1), (unsigned*)(ws + CTL_CNT1), LN_EPS};
        pg8::EpiLN<false> E{(const half_t*)(ws + WS_H0), nullptr, P.in[19], P.in[20], (half_t*)(ws + WS_H1), nullptr, st, tl};
        pg8::gemm_phase<pg8::EpiLN<false>>(lds, g, S, E);
    } SEAM(6);
    if (IN(7)) REP(7) {
        { pg8::Gemm g{(const half_t*)(ws + WS_H1), (const half_t*)(ws + WS_WGU), MTOK, 2 * DFF, DM}; pg8::StaticOrder S; S.init(MTOK, 2 * DFF, G, bx);
            pg8::EpiSwiGLU E{(half_t*)(ws + WS_ACT), DFF};
            pg8::gemm_phase<pg8::EpiSwiGLU>(lds, g, S, E); }
        { pg8::Gemm g{(const half_t*)(ws + WS_P16), (const half_t*)(ws + WS_WPLP), MTOK, DM, DPLE}; pg8::StaticOrder S; S.init(MTOK, DM, G, bx);
            pg8::EpiH E{(half_t*)(ws + WS_E2), DM, 0, nullptr};
            pg8::gemm_phase<pg8::EpiH>(lds, g, S, E); }
        { pg8::Gemm g{(const half_t*)(ws + WS_H1), (const half_t*)(ws + WS_WPLG), MTOK, DM, DM}; pg8::StaticOrder S; S.init(MTOK, DM, G, bx);
            pg8::EpiE E{(half_t*)(ws + WS_E2), DM};
            pg8::gemm_phase<pg8::EpiE>(lds, g, S, E); }
    } SEAM(7);
    if (IN(8)) {
        pg8::Gemm g{(const half_t*)(ws + WS_ACT), (const half_t*)(ws + WS_WDN), MTOK, DM, DFF}; pg8::StaticOrder S; S.init(MTOK, DM, G, bx);
        pg8::PanelStats st{(unsigned long long*)(ws + WS_XB2), (unsigned*)(ws + CTL_CNT2), LN_EPS};
        pg8::EpiLN<true> E{(const half_t*)(ws + WS_H1), (const half_t*)(ws + WS_E2), P.in[26], P.in[27], nullptr, P.out, st, tl};
        pg8::gemm_phase<pg8::EpiLN<true>>(lds, g, S, E);
    }
#undef IN
#undef SEAM
}

extern "C" void kernel_launch(void* const* d_in, const int* in_sizes, int n_in, void* d_out, int out_size, void* d_ws, size_t ws_size, hipStream_t stream) {
    static int grid_blocks = 0;
    if (grid_blocks == 0) {
        if (n_in != 28 || out_size != MTOK * DM || ws_size < WS_END) { fprintf(stderr, "kernel_launch: unexpected shapes (n_in %d, out %d, ws %zu, need %zu)\n", n_in, out_size, ws_size, (size_t)WS_END); grid_blocks = -1; return; }
        int dev = 0, cus = 0, per_cu = 0;
        (void)hipGetDevice(&dev);
        (void)hipDeviceGetAttribute(&cus, hipDeviceAttributeMultiprocessorCount, dev);
        if (hipFuncSetAttribute((const void*)fwd_megakernel, hipFuncAttributeMaxDynamicSharedMemorySize, LDS_TOTAL) != hipSuccess) { fprintf(stderr, "kernel_launch: hipFuncSetAttribute failed\n"); grid_blocks = -1; return; }
        if (hipOccupancyMaxActiveBlocksPerMultiprocessor(&per_cu, (const void*)fwd_megakernel, NTHREADS, LDS_TOTAL) != hipSuccess || per_cu < 1) { fprintf(stderr, "kernel_launch: occupancy query failed (%d)\n", per_cu); per_cu = 1; (void)hipGetLastError(); }
        grid_blocks = cus * per_cu;
    }
    if (grid_blocks < 0) return;
    Params p{};
    for (int i = 0; i < 28; ++i) p.in[i] = (const float*)d_in[i];
    p.out = (float*)d_out; p.ws = (unsigned char*)d_ws;
    static_assert(WS_XS == CTL_BYTES && WS_XS + XS_BYTES <= WS_WIN, "control words and exchange slots are one contiguous region");
    (void)hipMemsetAsync(d_ws, 0, CTL_BYTES + XS_BYTES, stream);
#if N_LAUNCH_MODE == 1
    p.ph_lo = 0; p.ph_hi = NPHASE;
    { void* args[] = {&p};
        hipError_t e = hipLaunchCooperativeKernel((const void*)fwd_megakernel, dim3(grid_blocks), dim3(NTHREADS), args, LDS_TOTAL, stream);
        if (e != hipSuccess) fprintf(stderr, "cooperative launch failed: %s (grid %d)\n", hipGetErrorString(e), grid_blocks); }
#else
    for (int ph = 0; ph < NPHASE; ++ph) {
        p.ph_lo = ph; p.ph_hi = ph + 1;
        void* args[] = {&p};
        hipError_t e = hipLaunchCooperativeKernel((const void*)fwd_megakernel, dim3(grid_blocks), dim3(NTHREADS), args, LDS_TOTAL, stream);
        if (e != hipSuccess) { fprintf(stderr, "launch %d failed: %s (grid %d)\n", ph, hipGetErrorString(e), grid_blocks); break; }
    }
#endif
}
```

```cpp
#include <hip/hip_runtime.h>
#include <hip/hip_cooperative_groups.h>
#include <cstdio>
namespace cg = cooperative_groups;

#ifndef N_LAUNCH_MODE
#define N_LAUNCH_MODE 1
#endif

#ifndef PROBE_DUP
#define PROBE_DUP 0
#endif
#define LAS __attribute__((address_space(3)))
typedef _Float16 half_t;
typedef _Float16 h8 __attribute__((ext_vector_type(8)));
typedef _Float16 h4 __attribute__((ext_vector_type(4)));
typedef _Float16 h2 __attribute__((ext_vector_type(2)));
typedef float f32x4 __attribute__((ext_vector_type(4)));
typedef float f32x2 __attribute__((ext_vector_type(2)));
typedef unsigned u32x4 __attribute__((ext_vector_type(4)));
typedef unsigned u32x2 __attribute__((ext_vector_type(2)));
typedef unsigned long long u64x2 __attribute__((ext_vector_type(2)));

constexpr int MTOK = 32768, SEQ = 2048, DM = 1024, NIN = 2304, RWW = 512, DFF = 2816, DPLE = 256, NH = 8;
constexpr float ALPHA = 1.189207115f;
constexpr float LN_EPS = 1e-5f, GN_EPS = 64e-5f;
constexpr int NTHREADS = 512;
constexpr int LDS_BYTES = 131072;
constexpr int LDS_TAB = LDS_BYTES + 64;
constexpr int LDS_TOTAL = LDS_TAB + 10240 + 64;
constexpr int NPHASE = 9;

constexpr size_t MiB = 1024 * 1024;
constexpr size_t WS_WIN = 5 * MiB;
constexpr size_t WS_WOUT = WS_WIN + (size_t)NIN * DM * 2;
constexpr size_t WS_WGU = WS_WOUT + (size_t)DM * DM * 2;
constexpr size_t WS_WDN = WS_WGU + (size_t)2 * DFF * DM * 2;
constexpr size_t WS_WPLG = WS_WDN + (size_t)DM * DFF * 2;
constexpr size_t WS_WPLP = WS_WPLG + (size_t)DM * DM * 2;
constexpr size_t WS_WLORA = WS_WPLP + (size_t)DM * DPLE * 2;
constexpr size_t WS_WPOOL = WS_WLORA + (size_t)1536 * 256 * 2;
constexpr size_t WS_WEND = WS_WPOOL + (size_t)512 * 512 * 2;
static_assert(WS_WEND <= 32 * MiB, "weights region");
constexpr size_t WS_BON = 30 * MiB;
constexpr size_t WS_H0 = 32 * MiB;
constexpr size_t WS_Z = 96 * MiB;
constexpr size_t WS_LO = 240 * MiB;
constexpr size_t WS_AL = 336 * MiB;
constexpr size_t WS_DP = 352 * MiB;
constexpr size_t WS_P16 = 384 * MiB;
constexpr size_t WS_Y = 400 * MiB;
constexpr size_t WS_XB1 = 464 * MiB;
constexpr size_t WS_XB2 = 465 * MiB;
constexpr size_t WS_XS = 128 * 1024;
constexpr size_t XS_BYTES = (size_t)128 * 2 * SEQ * 8;
constexpr size_t WS_END = 498 * MiB;
constexpr size_t CTL_CNT1 = 65536, CTL_CNT2 = 65536 + 32768, CTL_BYTES = 131072;
constexpr size_t WS_H1 = WS_Z;
constexpr size_t WS_ACT = WS_Z + 64 * MiB;
constexpr size_t WS_E2 = WS_Y;
static_assert(WS_ACT + (size_t)MTOK * DFF * 2 <= WS_AL, "ACT alias");

struct Params {
    const float* in[28];
    float* out;
    unsigned char* ws;
    int ph_lo, ph_hi;
};

__device__ __forceinline__ unsigned pk2h(float a, float b) { h2 v; v.x = (_Float16)a; v.y = (_Float16)b; return __builtin_bit_cast(unsigned, v); }
__device__ __forceinline__ float sigm(float x) { return __builtin_amdgcn_rcpf(1.0f + __builtin_amdgcn_exp2f(-1.44269504f * x)); }
template <int CTRL> __device__ __forceinline__ float dpp_get(float v) { return __int_as_float(__builtin_amdgcn_update_dpp(0, __float_as_int(v), CTRL, 0xF, 0xF, false)); }
__device__ __forceinline__ float red8(float v) { v += dpp_get<0xB1>(v); v += dpp_get<0x4E>(v); v += dpp_get<0x141>(v); return v; }
__device__ __forceinline__ float red16(float v) { v = red8(v); v += dpp_get<0x140>(v); return v; }
__device__ __forceinline__ float wave_sum(float v) { v = red16(v); v += __shfl_xor(v, 16); v += __shfl_xor(v, 32); return v; }


#define XB_TMO      128
#define XB_XCNT(j)  (256  + 64 * (j))
#define XB_XSUB(j)  (1280 + 64 * (j))
#define XB_XGEN(j)  (2304 + 64 * (j))
#define XB_TOP      3328
#define XB_TOPGEN   3392
#define XCD_BAR_WORDS 3456
#define XB_SPIN_CAP (1u << 20)
__device__ __forceinline__ unsigned xb_ld(unsigned* p)              { return __hip_atomic_load(p, __ATOMIC_RELAXED, __HIP_MEMORY_SCOPE_AGENT); }
__device__ __forceinline__ unsigned xb_add(unsigned* p, unsigned v) { return __hip_atomic_fetch_add(p, v, __ATOMIC_RELAXED, __HIP_MEMORY_SCOPE_AGENT); }
__device__ __forceinline__ unsigned xb_xcc_id() { return (unsigned)__builtin_amdgcn_s_getreg((3 << 11) | 20) & 0xFu; }
#define XB_SPIN(cond, bar) do { unsigned _sp = 0; while (cond) { __builtin_amdgcn_s_sleep(1); \
    if ((++_sp & 255u) == 0u) { if (xb_ld(&(bar)[XB_TMO])) break; if (_sp > XB_SPIN_CAP) { atomicAdd(&(bar)[XB_TMO], 1u); break; } } } } while (0)
struct XcdBarrier { unsigned* bar; unsigned x; volatile LAS unsigned* st; };
__device__ __forceinline__ XcdBarrier xcd_barrier_post(unsigned* bar, volatile LAS unsigned* st) {
    XcdBarrier b; b.bar = bar; b.x = xb_xcc_id(); b.st = st;
    if (threadIdx.x == 0) (void)xb_add(&bar[XB_XCNT(b.x)], 1u);
    return b;
}
__device__ __forceinline__ void xcd_barrier_complete(unsigned* bar, unsigned x, unsigned& nloc, unsigned& nx) {
    const unsigned G = gridDim.x * gridDim.y * gridDim.z;
    unsigned sum, cnt, mine, sp = 0u;
    for (;;) {
        sum = 0u; cnt = 0u; mine = 0u;
#pragma unroll
        for (unsigned j = 0; j < 16; ++j) { const unsigned c = xb_ld(&bar[XB_XCNT(j)]); sum += c; cnt += (c > 0u) ? 1u : 0u; mine = (j == x) ? c : mine; }
        if (sum == G) break;
        __builtin_amdgcn_s_sleep(1);
        if ((++sp & 255u) == 0u) { if (xb_ld(&bar[XB_TMO])) break; if (sp > XB_SPIN_CAP) { atomicAdd(&bar[XB_TMO], 1u); break; } }
    }
    nloc = mine > 0u ? mine : 1u; nx = cnt > 0u ? cnt : 1u;
}
__device__ __forceinline__ void xcd_barrier(const XcdBarrier& b) {
    asm volatile("s_waitcnt vmcnt(0)" ::: "memory");
    __syncthreads();
    if (threadIdx.x == 0) {
        unsigned* bar = b.bar;
        __builtin_amdgcn_s_waitcnt(0);
        unsigned nloc = b.st[0], nx = b.st[1];
        if (nloc == 0u) { xcd_barrier_complete(bar, b.x, nloc, nx); b.st[0] = nloc; b.st[1] = nx; }
        const unsigned old = xb_add(&bar[XB_XSUB(b.x)], 1u);
        const unsigned gen = old / nloc;
        if (old + 1u == (gen + 1u) * nloc) {
            __builtin_amdgcn_fence(__ATOMIC_RELEASE, "agent");
            asm volatile("s_waitcnt vmcnt(0)" ::: "memory");
            const unsigned og = xb_add(&bar[XB_TOP], 1u);
            const unsigned tg = og / nx;
            if (og + 1u == (tg + 1u) * nx) xb_add(&bar[XB_TOPGEN], 1u);
            else XB_SPIN(xb_ld(&bar[XB_TOPGEN]) == tg, bar);
            __builtin_amdgcn_fence(__ATOMIC_ACQUIRE, "agent");
            xb_add(&bar[XB_XGEN(b.x)], 1u);
            asm volatile("s_waitcnt vmcnt(0)" ::: "memory");
        } else {
            XB_SPIN(xb_ld(&bar[XB_XGEN(b.x)]) == gen, bar);
            __builtin_amdgcn_fence(__ATOMIC_ACQUIRE, "agent");
            asm volatile("s_waitcnt vmcnt(0)" ::: "memory");
        }
    }
    __syncthreads();
}

namespace pg8 {
constexpr int BM = 256, BK = 64, HALF = 128, HTB = HALF * BK * 2, STAGE_BYTES = 8 * HTB, NXCD = 8, WGM = 8;
__device__ __forceinline__ int lds_byte(int r, int c) { const int st = (r >> 4) * 2 + (c >> 5), rr = r & 15, cc = c & 31, ob = rr * 64 + cc * 2; return st * 1024 + (ob ^ (((ob >> 9) & 1) << 5)); }
__device__ __forceinline__ void stage_rc(int b, int& R, int& C) { const int st = b / 1024, sb = b % 1024, swz = sb ^ (((sb >> 9) & 1) << 5); R = (st >> 1) * 16 + swz / 64; C = (st & 1) * 32 + (swz % 64) / 2; }
__device__ __forceinline__ int perm32(int rho) { const int n = rho >> 4, i = rho & 15; return 8 * (i >> 2) + 4 * n + (i & 3); }

struct Unit { int pm, pn; };
struct Gemm { const half_t* A; const half_t* Bt; int M, N, K; };
struct StaticOrder {
    int nM, nN, nwg, G, c;
    __device__ void init(int M, int N, int G_, int c_) { nM = M / BM; nN = N / BM; nwg = nM * nN; G = G_; c = c_; }
    __device__ bool next(int i, Unit& u) const {
        const long L = (long)i * G + c; if (L >= nwg) return false;
        int wgid = (int)L; { const int q = nwg / NXCD, r = nwg % NXCD, xcd = wgid % NXCD, off = wgid / NXCD; wgid = (xcd < r ? xcd * (q + 1) : r * (q + 1) + (xcd - r) * q) + off; }
        const int nig = WGM * nN, gid = wgid / nig, fm = gid * WGM, gsz = (nM - fm) < WGM ? (nM - fm) : WGM;
        u.pm = fm + ((wgid % nig) % gsz); u.pn = (wgid % nig) / gsz; return true;
    }
};


struct EpiH {
    static constexpr bool PERM = true, SYNC = false;
    half_t* O; int ldc; int coff; const float* scale;
    __device__ __forceinline__ void operator()(const f32x4 (&acc)[2][2][4][2], const Unit& u, int wr, int wc, int fr, int fq) const {
        const int row0 = u.pm * BM + wr * 64 + fr, col0 = u.pn * BM + wc * 32 + 8 * fq;
        f32x4 sv[2][2];
#pragma unroll
        for (int bj = 0; bj < 2; ++bj)
#pragma unroll
            for (int n = 0; n < 2; ++n) sv[bj][n] = scale ? *(const f32x4*)(scale + col0 + bj * HALF + 4 * n) : (f32x4){1.f, 1.f, 1.f, 1.f};
#pragma unroll
        for (int ai = 0; ai < 2; ++ai)
#pragma unroll
            for (int m = 0; m < 4; ++m) { half_t* rowp = O + (size_t)(row0 + ai * HALF + m * 16) * ldc + coff + col0;
#pragma unroll
                for (int bj = 0; bj < 2; ++bj) { const f32x4 v0 = acc[ai][bj][m][0] * sv[bj][0], v1 = acc[ai][bj][m][1] * sv[bj][1];
                    u32x4 w; w.x = pk2h(v0[0], v0[1]); w.y = pk2h(v0[2], v0[3]); w.z = pk2h(v1[0], v1[1]); w.w = pk2h(v1[2], v1[3]);
                    *(u32x4*)(rowp + bj * HALF) = w; } }
    }
};
struct EpiSwiGLU {
    static constexpr bool PERM = true, SYNC = false;
    half_t* O; int ldc;
    __device__ __forceinline__ void operator()(const f32x4 (&acc)[2][2][4][2], const Unit& u, int wr, int wc, int fr, int fq) const {
        const int row0 = u.pm * BM + wr * 64 + fr, col0 = u.pn * HALF + wc * 32 + 8 * fq;
#pragma unroll
        for (int ai = 0; ai < 2; ++ai)
#pragma unroll
            for (int m = 0; m < 4; ++m) { half_t* rowp = O + (size_t)(row0 + ai * HALF + m * 16) * ldc + col0;
                float r[8];
#pragma unroll
                for (int n = 0; n < 2; ++n)
#pragma unroll
                    for (int j = 0; j < 4; ++j) { const float g = acc[ai][0][m][n][j], up = acc[ai][1][m][n][j]; r[n * 4 + j] = g * sigm(g) * up; }
                u32x4 w; w.x = pk2h(r[0], r[1]); w.y = pk2h(r[2], r[3]); w.z = pk2h(r[4], r[5]); w.w = pk2h(r[6], r[7]);
                *(u32x4*)rowp = w; }
    }
};
struct EpiE {
    static constexpr bool PERM = true, SYNC = false;
    half_t* E; int ldc;
    __device__ __forceinline__ void operator()(const f32x4 (&acc)[2][2][4][2], const Unit& u, int wr, int wc, int fr, int fq) const {
        const int row0 = u.pm * BM + wr * 64 + fr, col0 = u.pn * BM + wc * 32 + 8 * fq;
#pragma unroll
        for (int ai = 0; ai < 2; ++ai)
#pragma unroll
            for (int m = 0; m < 4; ++m) { half_t* rowp = E + (size_t)(row0 + ai * HALF + m * 16) * ldc + col0;
#pragma unroll
                for (int bj = 0; bj < 2; ++bj) {
                    const unsigned long long* ep = (const unsigned long long*)(rowp + bj * HALF);
                    u64x2 e01; e01.x = __hip_atomic_load(ep, __ATOMIC_RELAXED, __HIP_MEMORY_SCOPE_AGENT); e01.y = __hip_atomic_load(ep + 1, __ATOMIC_RELAXED, __HIP_MEMORY_SCOPE_AGENT);
                    const h8 e = __builtin_bit_cast(h8, e01); float r[8];
#pragma unroll
                    for (int n = 0; n < 2; ++n)
#pragma unroll
                        for (int j = 0; j < 4; ++j) r[n * 4 + j] = sigm(acc[ai][bj][m][n][j]) * (float)e[n * 4 + j];
                    u32x4 w; w.x = pk2h(r[0], r[1]); w.y = pk2h(r[2], r[3]); w.z = pk2h(r[4], r[5]); w.w = pk2h(r[6], r[7]);
                    *(u32x4*)(rowp + bj * HALF) = w; } }
    }
};
template <bool HAS2> struct EpiRes {
    static constexpr bool PERM = false, SYNC = false;
    float* C; const half_t* R1; const half_t* R2; int ldc;
    __device__ __forceinline__ void operator()(const f32x4 (&acc)[2][2][4][2], const Unit& u, int wr, int wc, int fr, int fq) const {
        const int row0 = u.pm * BM + wr * 64 + fr, col0 = u.pn * BM + wc * 32 + 4 * fq;
#pragma unroll
        for (int ai = 0; ai < 2; ++ai)
#pragma unroll
            for (int m = 0; m < 4; ++m) { const size_t off = (size_t)(row0 + ai * HALF + m * 16) * ldc + col0;
#pragma unroll
                for (int bj = 0; bj < 2; ++bj)
#pragma unroll
                    for (int n = 0; n < 2; ++n) { const size_t o = off + bj * HALF + n * 16; const h4 a = *(const h4*)(R1 + o);
                        f32x4 v = acc[ai][bj][m][n]; v[0] += ALPHA * (float)a[0]; v[1] += ALPHA * (float)a[1]; v[2] += ALPHA * (float)a[2]; v[3] += ALPHA * (float)a[3];
                        if (HAS2) { const h4 e = *(const h4*)(R2 + o); v[0] += (float)e[0]; v[1] += (float)e[1]; v[2] += (float)e[2]; v[3] += (float)e[3]; }
                        *(f32x4*)(C + o) = v; } }
    }
};


struct PanelStats {
    unsigned long long* xbuf; unsigned* cnt; float eps;
    __device__ __forceinline__ void run(const f32x4 (&v)[2][2][4][2], const Unit& u, int wr, int wc, int fr, int fq, LAS unsigned char* tl, int wid, int lane) const {
        LAS f32x2* Pt = (LAS f32x2*)tl; LAS f32x2* St = (LAS f32x2*)(tl + 8192);
#pragma unroll
        for (int ai = 0; ai < 2; ++ai)
#pragma unroll
            for (int m = 0; m < 4; ++m) {
                float s = 0.f;
#pragma unroll
                for (int bj = 0; bj < 2; ++bj)
#pragma unroll
                    for (int n = 0; n < 2; ++n) { const f32x4 x = v[ai][bj][m][n]; s += (x[0] + x[1]) + (x[2] + x[3]); }
                s += __shfl_xor(s, 16); s += __shfl_xor(s, 32);
                const float mw = s * (1.0f / 64.0f); float q = 0.f;
#pragma unroll
                for (int bj = 0; bj < 2; ++bj)
#pragma unroll
                    for (int n = 0; n < 2; ++n) { const f32x4 d = v[ai][bj][m][n] - mw; q += (d[0] * d[0] + d[1] * d[1]) + (d[2] * d[2] + d[3] * d[3]); }
                q += __shfl_xor(q, 16); q += __shfl_xor(q, 32);
                if (fq == 0) Pt[(ai * HALF + wr * 64 + m * 16 + fr) * 4 + wc] = (f32x2){mw, q};
            }
        asm volatile("s_waitcnt lgkmcnt(0)" ::: "memory"); __builtin_amdgcn_s_barrier(); asm volatile("" ::: "memory");
        const int row = wid * 32 + (lane & 31);
        if (lane < 32) {
            const f32x2 a = Pt[row * 4 + 0], b = Pt[row * 4 + 1], c = Pt[row * 4 + 2], d = Pt[row * 4 + 3];
            const float mt = (a.x + b.x + c.x + d.x) * 0.25f;
            const float da = a.x - mt, db = b.x - mt, dc = c.x - mt, dd = d.x - mt;
            const float m2 = (a.y + b.y) + (c.y + d.y) + 64.0f * ((da * da + db * db) + (dc * dc + dd * dd));
            unsigned long long* slot = xbuf + ((size_t)(u.pm * BM + row) * 4 + u.pn);
            __hip_atomic_store(slot, ((unsigned long long)__float_as_uint(m2) << 32) | __float_as_uint(mt), __ATOMIC_RELAXED, __HIP_MEMORY_SCOPE_AGENT);
        }
        asm volatile("s_waitcnt vmcnt(0)" ::: "memory");
        if (lane == 0) __hip_atomic_fetch_add(cnt + 64 * u.pm, 1u, __ATOMIC_RELAXED, __HIP_MEMORY_SCOPE_AGENT);
        if (wid == 0) {
            unsigned sp = 0;
            while ((unsigned)__builtin_amdgcn_readfirstlane(__hip_atomic_load(cnt + 64 * u.pm, __ATOMIC_RELAXED, __HIP_MEMORY_SCOPE_AGENT)) < 32u) { __builtin_amdgcn_s_sleep(2); if (++sp > (1u << 22)) break; }
            __builtin_amdgcn_fence(__ATOMIC_ACQUIRE, "agent");
        }
        asm volatile("s_waitcnt vmcnt(0) lgkmcnt(0)" ::: "memory"); __builtin_amdgcn_s_barrier(); asm volatile("" ::: "memory");
        if (lane < 32) {
            const unsigned long long* slot = xbuf + (size_t)(u.pm * BM + row) * 4; float mt[4], m2[4]; float ms = 0.f;
#pragma unroll
            for (int t = 0; t < 4; ++t) { const unsigned long long w = __hip_atomic_load(slot + t, __ATOMIC_RELAXED, __HIP_MEMORY_SCOPE_AGENT); mt[t] = __uint_as_float((unsigned)w); m2[t] = __uint_as_float((unsigned)(w >> 32)); ms += mt[t]; }
            const float mean = ms * 0.25f; float q = 0.f;
#pragma unroll
            for (int t = 0; t < 4; ++t) { const float dm = mt[t] - mean; q += m2[t] + 256.0f * dm * dm; }
            St[row] = (f32x2){mean, __builtin_amdgcn_rsqf(q * (1.0f / 1024.0f) + eps)};
        }
        asm volatile("s_waitcnt lgkmcnt(0)" ::: "memory"); __builtin_amdgcn_s_barrier(); asm volatile("" ::: "memory");
    }
};
template <bool FINAL> struct EpiLN {
    static constexpr bool PERM = false, SYNC = true;
    const half_t* R1; const half_t* R2; const float* g; const float* b; half_t* H; float* C; PanelStats st; LAS unsigned char* tl;
    __device__ __forceinline__ void operator()(f32x4 (&acc)[2][2][4][2], const Unit& u, int wr, int wc, int fr, int fq) const {
        const int lane = threadIdx.x & 63, wid = __builtin_amdgcn_readfirstlane(threadIdx.x >> 6);
        const int row0 = u.pm * BM + wr * 64 + fr, col0 = u.pn * BM + wc * 32 + 4 * fq;
#pragma unroll
        for (int ai = 0; ai < 2; ++ai)
#pragma unroll
            for (int m = 0; m < 4; ++m) { const size_t off = (size_t)(row0 + ai * HALF + m * 16) * DM + col0;
#pragma unroll
                for (int bj = 0; bj < 2; ++bj)
#pragma unroll
                    for (int n = 0; n < 2; ++n) { const size_t o = off + bj * HALF + n * 16; const h4 a = *(const h4*)(R1 + o);
                        f32x4 v = acc[ai][bj][m][n]; v[0] += ALPHA * (float)a[0]; v[1] += ALPHA * (float)a[1]; v[2] += ALPHA * (float)a[2]; v[3] += ALPHA * (float)a[3];
                        if (FINAL) { const h4 e = *(const h4*)(R2 + o); v[0] += (float)e[0]; v[1] += (float)e[1]; v[2] += (float)e[2]; v[3] += (float)e[3]; }
                        acc[ai][bj][m][n] = v; }
                asm volatile("" : "+v"(acc[ai][0][m][0]), "+v"(acc[ai][0][m][1]), "+v"(acc[ai][1][m][0]), "+v"(acc[ai][1][m][1]));
                asm volatile("" ::: "memory"); }
        f32x4 gvv[2][2], bvv[2][2];
#pragma unroll
        for (int bj = 0; bj < 2; ++bj)
#pragma unroll
            for (int n = 0; n < 2; ++n) { gvv[bj][n] = *(const f32x4*)(g + col0 + bj * HALF + n * 16); bvv[bj][n] = *(const f32x4*)(b + col0 + bj * HALF + n * 16); }
        st.run(acc, u, wr, wc, fr, fq, tl, wid, lane);
        const LAS f32x2* St = (const LAS f32x2*)(tl + 8192);
#pragma unroll
        for (int ai = 0; ai < 2; ++ai)
#pragma unroll
            for (int m = 0; m < 4; ++m) { const int r = ai * HALF + wr * 64 + m * 16 + fr; const f32x2 sr = St[r]; const size_t off = (size_t)(u.pm * BM + r) * DM + col0;
#pragma unroll
                for (int bj = 0; bj < 2; ++bj)
#pragma unroll
                    for (int n = 0; n < 2; ++n) {
                        const f32x4 o = (acc[ai][bj][m][n] - sr.x) * sr.y * gvv[bj][n] + bvv[bj][n]; const size_t oo = off + bj * HALF + n * 16;
                        if (FINAL) *(f32x4*)(C + oo) = o;
                        else { u32x2 w; w.x = pk2h(o[0], o[1]); w.y = pk2h(o[2], o[3]); *(u32x2*)(H + oo) = w; } }
                asm volatile("" ::: "memory"); }
        asm volatile("s_waitcnt lgkmcnt(0)" ::: "memory"); __builtin_amdgcn_s_barrier(); asm volatile("" ::: "memory");
    }
};

template <class Epi>
__device__ __forceinline__ void gemm_phase(LAS unsigned char* lds, const Gemm g, const StaticOrder& S, const Epi& E) {
    const int tid = threadIdx.x, wid = __builtin_amdgcn_readfirstlane(tid >> 6), lane = tid & 63, wr = wid >> 2, wc = wid & 3, fr = lane & 15, fq = lane >> 4;
    const int K = g.K, nt = K / BK;
    unsigned voffA[2], voffB[2];
#pragma unroll
    for (int i = 0; i < 2; ++i) { int R, C; stage_rc(tid * 16 + i * 8192, R, C); const int Rb = Epi::PERM ? ((R & ~31) + perm32(R & 31)) : R;
        voffA[i] = (unsigned)(R * K + C) * 2u; voffB[i] = (unsigned)(Rb * K + C) * 2u; }
    const size_t kstep = (size_t)(BK * 2);
    const size_t hstep = (size_t)HALF * K * 2;
    const size_t tstep = 2 * hstep;
    const unsigned ldsw = (unsigned)wid * 1024u;
    const int aoff = lds_byte(wr * 64 + fr, fq * 8), boff = lds_byte(wc * 32 + fr, fq * 8);
#define PG8_SA(b, h) (((b) * 2 + (h)) * HTB)
#define PG8_SB(b, h) ((4 + (b) * 2 + (h)) * HTB)
#define PG8_STAGE(bufoff, gbase, voff) do { _Pragma("unroll") for (int _i = 0; _i < 2; ++_i) \
        __builtin_amdgcn_global_load_lds((const unsigned*)((const char*)(gbase) + (voff)[_i]), (LAS unsigned*)(lds + (bufoff) + ldsw + _i * 8192), 16, 0, 0); } while (0)
#define PG8_LDA(dst, b, h) do { _Pragma("unroll") for (int m = 0; m < 4; ++m) _Pragma("unroll") for (int k = 0; k < 2; ++k) dst[m][k] = *(const LAS h8*)(lds + PG8_SA(b, h) + aoff + m * 2048 + k * 1024); } while (0)
#define PG8_LDB(dst, b, h) do { _Pragma("unroll") for (int n = 0; n < 2; ++n) _Pragma("unroll") for (int k = 0; k < 2; ++k) dst[n][k] = *(const LAS h8*)(lds + PG8_SB(b, h) + boff + n * 2048 + k * 1024); } while (0)
#define PG8_MMA(ai, bj, At, Bt) do { __builtin_amdgcn_s_setprio(1); _Pragma("unroll") for (int m = 0; m < 4; ++m) _Pragma("unroll") for (int n = 0; n < 2; ++n) _Pragma("unroll") for (int k = 0; k < 2; ++k) \
        acc[ai][bj][m][n] = __builtin_amdgcn_mfma_f32_16x16x32_f16(Bt[n][k], At[m][k], acc[ai][bj][m][n], 0, 0, 0); __builtin_amdgcn_s_setprio(0); } while (0)
#define PG8_WAIT_V(n) asm volatile("s_waitcnt vmcnt(" #n ")" ::: "memory")
#define PG8_WAIT_L(n) asm volatile("s_waitcnt lgkmcnt(" #n ")" ::: "memory")
#define PG8_BAR __builtin_amdgcn_s_barrier()
#define PG8_SCHED __builtin_amdgcn_sched_barrier(0)
    Unit cur, nxt; int ui = 0;
    if (!S.next(0, cur)) return;
    f32x4 acc[2][2][4][2];
#pragma unroll
    for (int a = 0; a < 2; ++a)
#pragma unroll
        for (int b = 0; b < 2; ++b)
#pragma unroll
            for (int m = 0; m < 4; ++m)
#pragma unroll
                for (int n = 0; n < 2; ++n) acc[a][b][m][n] = (f32x4){0.f, 0.f, 0.f, 0.f};
    h8 At[4][2], B0[2][2], B1[2][2];
    const char* cA = (const char*)g.A + (size_t)cur.pm * tstep; const char* cB = (const char*)g.Bt + (size_t)cur.pn * tstep;
    PG8_STAGE(PG8_SB(0, 0), cB, voffB); PG8_STAGE(PG8_SB(0, 1), cB + hstep, voffB); PG8_STAGE(PG8_SA(0, 0), cA, voffA); PG8_STAGE(PG8_SA(0, 1), cA + hstep, voffA);
    if (wr == 1) PG8_BAR;
    PG8_WAIT_V(2); PG8_BAR;
    PG8_STAGE(PG8_SB(1, 0), cB + kstep, voffB); PG8_STAGE(PG8_SA(1, 0), cA + kstep, voffA); PG8_STAGE(PG8_SB(1, 1), cB + hstep + kstep, voffB);
    PG8_WAIT_V(6); PG8_BAR;
    for (;;) {
        const bool has_next = S.next(ui + 1, nxt);
        const char* nA = has_next ? (const char*)g.A + (size_t)nxt.pm * tstep : cA; const char* nB = has_next ? (const char*)g.Bt + (size_t)nxt.pn * tstep : cB;
        for (int t = 0; t < nt; t += 2) {
            const bool last = (t == nt - 2);
            const char* a1 = cA + (size_t)(t + 1) * kstep;
            const char* a2 = last ? nA : cA + (size_t)(t + 2) * kstep; const char* b2 = last ? nB : cB + (size_t)(t + 2) * kstep;
            const char* a3 = a2 + kstep; const char* b3 = b2 + kstep;
            PG8_LDB(B0, 0, 0); PG8_LDB(B1, 0, 1); PG8_SCHED; PG8_LDA(At, 0, 0); PG8_STAGE(PG8_SA(1, 1), a1 + hstep, voffA);
            PG8_WAIT_V(8); PG8_WAIT_L(0); PG8_BAR; PG8_MMA(0, 0, At, B0); PG8_MMA(0, 1, At, B1); PG8_BAR; PG8_SCHED;
            PG8_LDA(At, 0, 1); PG8_STAGE(PG8_SB(0, 0), b2, voffB); PG8_STAGE(PG8_SB(0, 1), b2 + hstep, voffB); PG8_STAGE(PG8_SA(0, 0), a2, voffA);
            PG8_WAIT_V(8); PG8_WAIT_L(0); PG8_BAR; PG8_MMA(1, 0, At, B0); PG8_MMA(1, 1, At, B1); PG8_BAR; PG8_SCHED;
            PG8_LDB(B0, 1, 0); PG8_LDB(B1, 1, 1); PG8_SCHED; PG8_LDA(At, 1, 0); PG8_STAGE(PG8_SA(0, 1), a2 + hstep, voffA);
            PG8_WAIT_V(8); PG8_WAIT_L(0); PG8_BAR; PG8_MMA(0, 0, At, B0); PG8_MMA(0, 1, At, B1); PG8_BAR; PG8_SCHED;
            PG8_LDA(At, 1, 1); PG8_STAGE(PG8_SB(1, 0), b3, voffB); PG8_STAGE(PG8_SB(1, 1), b3 + hstep, voffB); PG8_STAGE(PG8_SA(1, 0), a3, voffA);
            PG8_WAIT_V(8); PG8_WAIT_L(0); PG8_BAR; PG8_MMA(1, 0, At, B0); PG8_MMA(1, 1, At, B1); PG8_BAR; PG8_SCHED;
        }
        if (wr == 0) PG8_BAR;
        E(acc, cur, wr, wc, fr, fq);
        if (wr == 1) PG8_BAR;
        if (!has_next) break;
#pragma unroll
        for (int a = 0; a < 2; ++a)
#pragma unroll
            for (int b = 0; b < 2; ++b)
#pragma unroll
                for (int m = 0; m < 4; ++m)
#pragma unroll
                    for (int n = 0; n < 2; ++n) acc[a][b][m][n] = (f32x4){0.f, 0.f, 0.f, 0.f};
        cur = nxt; cA = nA; cB = nB; ++ui;
    }
    PG8_WAIT_V(0);
    if (wr == 0) PG8_BAR;
    PG8_BAR;
#undef PG8_SA
#undef PG8_SB
#undef PG8_STAGE
#undef PG8_LDA
#undef PG8_LDB
#undef PG8_MMA
#undef PG8_WAIT_V
#undef PG8_WAIT_L
#undef PG8_BAR
#undef PG8_SCHED
}
}

__device__ __forceinline__ void transpose_tile(LAS float* tile, const float* __restrict__ src, int N, int k0, int n0, half_t* __restrict__ dst, int ldd, int drow0) {
    const int tid = threadIdx.x;
#pragma unroll
    for (int i = 0; i < 8; ++i) { const int kk = i * 8 + (tid >> 6), nn = tid & 63; tile[kk * 65 + nn] = src[(size_t)(k0 + kk) * N + n0 + nn]; }
    __syncthreads();
    { const int n = tid >> 3, kq = tid & 7; float v[8];
#pragma unroll
        for (int j = 0; j < 8; ++j) v[j] = tile[(kq * 8 + j) * 65 + n];
        u32x4 w; w.x = pk2h(v[0], v[1]); w.y = pk2h(v[2], v[3]); w.z = pk2h(v[4], v[5]); w.w = pk2h(v[6], v[7]);
        *(u32x4*)(dst + (size_t)(drow0 + n) * ldd + k0 + kq * 8) = w; }
    __syncthreads();
}

__device__ __forceinline__ void ln_row_to_f16(const float* __restrict__ xrow, const float* __restrict__ g, const float* __restrict__ b, half_t* __restrict__ orow, int lane) {
    f32x4 v[4]; float s = 0.f;
#pragma unroll
    for (int j = 0; j < 4; ++j) { v[j] = *(const f32x4*)(xrow + j * 256 + lane * 4); s += (v[j][0] + v[j][1]) + (v[j][2] + v[j][3]); }
    const float mu = wave_sum(s) * (1.0f / 1024.0f); float q = 0.f;
#pragma unroll
    for (int j = 0; j < 4; ++j) { v[j] = v[j] - mu; q += (v[j][0] * v[j][0] + v[j][1] * v[j][1]) + (v[j][2] * v[j][2] + v[j][3] * v[j][3]); }
    const float rstd = __builtin_amdgcn_rsqf(wave_sum(q) * (1.0f / 1024.0f) + LN_EPS);
#pragma unroll
    for (int j = 0; j < 4; ++j) { const f32x4 gg = *(const f32x4*)(g + j * 256 + lane * 4), bb = *(const f32x4*)(b + j * 256 + lane * 4); const f32x4 o = v[j] * rstd * gg + bb;
        u32x2 w; w.x = pk2h(o[0], o[1]); w.y = pk2h(o[2], o[3]); *(u32x2*)(orow + j * 256 + lane * 4) = w; }
}

__device__ void phase_prologue(LAS unsigned char* lds, const Params& P) {
    unsigned char* ws = P.ws;
    const int tid = threadIdx.x, G = gridDim.x, bx = blockIdx.x;
    LAS float* tile = (LAS float*)lds;
    const int T0 = 16 * 28, T1 = T0 + 16 * 16, T2 = T1 + 16 * 44, T3 = T2 + 16 * 44, T4 = T3 + 44 * 16, T5 = T4 + 16 * 16, T6 = T5 + 4 * 16;
    for (int t = bx; t < T0; t += G) {
        const float* src; int N, loc, ldd, kind = 0, ncols = 0; half_t* dst;
        if (t < T0) { src = P.in[4]; N = NIN; ncols = 1792; loc = t; dst = (half_t*)(ws + WS_WIN); ldd = DM; }
        else if (t < T1) { src = P.in[18]; N = DM; loc = t - T0; dst = (half_t*)(ws + WS_WOUT); ldd = DM; }
        else if (t < T2) { src = P.in[21]; N = DFF; loc = t - T1; dst = (half_t*)(ws + WS_WGU); ldd = DM; kind = 1; }
        else if (t < T3) { src = P.in[22]; N = DFF; loc = t - T2; dst = (half_t*)(ws + WS_WGU); ldd = DM; kind = 2; }
        else if (t < T4) { src = P.in[23]; N = DM; loc = t - T3; dst = (half_t*)(ws + WS_WDN); ldd = DFF; }
        else if (t < T5) { src = P.in[25]; N = DM; loc = t - T4; dst = (half_t*)(ws + WS_WPLG); ldd = DM; }
        else { src = P.in[24]; N = DM; loc = t - T5; dst = (half_t*)(ws + WS_WPLP); ldd = DPLE; }
        const int ntn = (ncols ? ncols : N) / 64, kt = loc / ntn, nt_ = loc % ntn, n0 = nt_ * 64;
        int drow0 = n0;
        if (kind) drow0 = (n0 >> 7) * 256 + (n0 & 127) + (kind == 2 ? 128 : 0);
        transpose_tile(tile, src, N, kt * 64, n0, dst, ldd, drow0);
    }
    const int gtid = bx * NTHREADS + tid, gth = G * NTHREADS;
    { half_t* wl = (half_t*)(ws + WS_WLORA);
        for (int i = gtid; i < 1536 * 256; i += gth) { const int n = i >> 8, k = i & 255; float v = 0.f;
            if (n < 512) { if (k < 64) v = P.in[7][k * 512 + n]; }
            else if (n < 1024) { if (k >= 64 && k < 128) v = P.in[9][(k - 64) * 512 + (n - 512)]; }
            else { if (k >= 128) v = P.in[10][(k - 128) * 512 + (n - 1024)]; }
            wl[i] = (half_t)v; } }
    { half_t* wt_in = (half_t*)(ws + WS_WIN); LAS float* Pw = (LAS float*)lds; LAS float* Wl = (LAS float*)(lds + 65536);
        for (int job = bx; job < 256; job += G) {
            const int g = job >> 6, k0 = (job & 63) * 16;
            __syncthreads();
            for (int i = tid; i < 4096; i += NTHREADS) *(LAS f32x4*)(Pw + i * 4) = *(const f32x4*)(P.in[16] + (size_t)g * 16384 + i * 4);
            { const int r = tid >> 5, c4 = (tid & 31) * 4; *(LAS f32x4*)(Wl + r * 128 + c4) = *(const f32x4*)(P.in[4] + (size_t)(k0 + r) * NIN + 1792 + g * 128 + c4); }
            __syncthreads();
            const int d = tid & 127, kr = tid >> 7; float acc[4] = {0.f, 0.f, 0.f, 0.f};
#pragma unroll 4
            for (int c = 0; c < 128; c += 4) {
                const float p0 = Pw[c * 128 + d], p1 = Pw[(c + 1) * 128 + d], p2 = Pw[(c + 2) * 128 + d], p3 = Pw[(c + 3) * 128 + d];
#pragma unroll
                for (int j = 0; j < 4; ++j) { const f32x4 wv = *(const LAS f32x4*)(Wl + (kr * 4 + j) * 128 + c); acc[j] += wv[0] * p0 + wv[1] * p1 + wv[2] * p2 + wv[3] * p3; } }
            u32x2 w; w.x = pk2h(acc[0], acc[1]); w.y = pk2h(acc[2], acc[3]);
            *(u32x2*)(wt_in + (size_t)(1792 + g * 128 + d) * DM + k0 + kr * 4) = w;
        }
        __syncthreads(); }
    { const int lane = tid & 63, wv = tid >> 6; half_t* h0 = (half_t*)(ws + WS_H0);
        f32x4 gg[4], bb[4];
#pragma unroll
        for (int j = 0; j < 4; ++j) { gg[j] = *(const f32x4*)(P.in[2] + j * 256 + lane * 4); bb[j] = *(const f32x4*)(P.in[3] + j * 256 + lane * 4); }
        for (int row = (bx * 8 + wv) * 2; row < MTOK; row += G * 16) {
            f32x4 v[2][4];
#pragma unroll
            for (int r = 0; r < 2; ++r)
#pragma unroll
                for (int j = 0; j < 4; ++j) v[r][j] = __builtin_nontemporal_load((const f32x4*)(P.in[0] + (size_t)(row + r) * DM + j * 256 + lane * 4));
#pragma unroll
            for (int r = 0; r < 2; ++r) {
                float s_ = 0.f;
#pragma unroll
                for (int j = 0; j < 4; ++j) s_ += (v[r][j][0] + v[r][j][1]) + (v[r][j][2] + v[r][j][3]);
                const float mu = wave_sum(s_) * (1.0f / 1024.0f); float q = 0.f;
#pragma unroll
                for (int j = 0; j < 4; ++j) { v[r][j] = v[r][j] - mu; q += (v[r][j][0] * v[r][j][0] + v[r][j][1] * v[r][j][1]) + (v[r][j][2] * v[r][j][2] + v[r][j][3] * v[r][j][3]); }
                const float rstd = __builtin_amdgcn_rsqf(wave_sum(q) * (1.0f / 1024.0f) + LN_EPS);
#pragma unroll
                for (int j = 0; j < 4; ++j) { const f32x4 o = v[r][j] * rstd * gg[j] + bb[j]; u32x2 w; w.x = pk2h(o[0], o[1]); w.y = pk2h(o[2], o[3]); *(u32x2*)(h0 + (size_t)(row + r) * DM + j * 256 + lane * 4) = w; }
            }
        }
    }
}

template <int W> __device__ __forceinline__ void pool_group(const half_t* __restrict__ Z, half_t* __restrict__ Y, const float* __restrict__ scale, int g, int gtid, int gth) {
    for (int i = gtid; i < MTOK * 16; i += gth) {
        const int m = i >> 4, jc = g * 16 + (i & 15), t = m & (SEQ - 1);
        const half_t* zp = Z + (size_t)m * NIN + 1792 + jc * 8;
        h8 u[W];
#pragma unroll
        for (int q = 0; q < W; ++q) { if (q <= t) u[q] = *(const h8*)(zp - (size_t)q * NIN); else u[q] = (h8){0, 0, 0, 0, 0, 0, 0, 0}; }
        const int cnt = (t + 1) < W ? (t + 1) : W; const float inv = 1.0f / (float)cnt; float r[8];
#pragma unroll
        for (int e = 0; e < 8; ++e) { float s = 0.f;
#pragma unroll
            for (int q = 0; q < W; ++q) s += (float)u[q][e];
            r[e] = (s * inv - (float)u[0][e]) * scale[jc * 8 + e]; }
        u32x4 w; w.x = pk2h(r[0], r[1]); w.y = pk2h(r[2], r[3]); w.z = pk2h(r[4], r[5]); w.w = pk2h(r[6], r[7]);
        *(u32x4*)(Y + (size_t)m * DM + 512 + jc * 8) = w;
    }
}
__device__ void phase_prep(const Params& P) {
    unsigned char* ws = P.ws;
    const half_t* Z = (const half_t*)(ws + WS_Z); half_t* AL = (half_t*)(ws + WS_AL); half_t* Yb = (half_t*)(ws + WS_Y);
    const float* mu = P.in[5];
    const int gtid = blockIdx.x * NTHREADS + threadIdx.x, gth = gridDim.x * NTHREADS;
    for (int i = gtid; i < MTOK * 32; i += gth) {
        const int m = i >> 5, j = i & 31, t = m & (SEQ - 1);
        const half_t* zrow = Z + (size_t)m * NIN;
        const int cz = 1536 + j * 8;
        const h8 zc = *(const h8*)(zrow + cz); h8 zp;
        if (t > 0) zp = *(const h8*)(zrow - NIN + cz); else zp = (h8){0, 0, 0, 0, 0, 0, 0, 0};
        const f32x4 m0 = *(const f32x4*)(mu + cz), m1 = *(const f32x4*)(mu + cz + 4); float r[8];
#pragma unroll
        for (int e = 0; e < 8; ++e) { const float zz = (float)zc[e], mm = e < 4 ? m0[e & 3] : m1[e & 3]; float v = zz + ((float)zp[e] - zz) * mm;
            if (j < 8) { const float tt = __builtin_amdgcn_exp2f(2.88539008f * v); v = 1.0f - 2.0f * __builtin_amdgcn_rcpf(1.0f + tt); }
            else if (j >= 16) v = sigm(v);
            r[e] = v; }
        u32x4 w; w.x = pk2h(r[0], r[1]); w.y = pk2h(r[2], r[3]); w.z = pk2h(r[4], r[5]); w.w = pk2h(r[6], r[7]);
        *(u32x4*)(AL + (size_t)m * 256 + j * 8) = w;
    }
    pool_group<2>(Z, Yb, P.in[17], 0, gtid, gth);
    pool_group<4>(Z, Yb, P.in[17], 1, gtid, gth);
    pool_group<8>(Z, Yb, P.in[17], 2, gtid, gth);
    pool_group<16>(Z, Yb, P.in[17], 3, gtid, gth);
}

constexpr int TC = 32;
constexpr int STEPF = 320;
constexpr int SC_BUF = 0, SC_SCAL = 2 * TC * STEPF * 4, SC_YB = SC_SCAL + 2 * TC * 4 * 4, SC_VR = SC_YB + 4 * 32 * 33 * 4, SC_BR = SC_VR + 4 * TC * 32 * 2, SC_CST = SC_BR + 4 * TC * 8, SC_VT = SC_CST + 8 * 64 * 4, SC_END = SC_VT + 2 * 32 * TC * 4;
static_assert(SC_END <= LDS_BYTES, "scan lds");

__device__ __forceinline__ float wave_sum_dpp(float v) {
    v = red16(v);
    v += __int_as_float(__builtin_amdgcn_update_dpp(0, __float_as_int(v), 0x142, 0xA, 0xF, false));
    v += __int_as_float(__builtin_amdgcn_update_dpp(0, __float_as_int(v), 0x143, 0xC, 0xF, false));
    return __int_as_float(__builtin_amdgcn_readlane(__float_as_int(v), 63));
}

struct ScanRaw { h8 zr, zk, zv, pr, pk, pv, lw, la; };
struct ScanStep { f32x4 kkA, kkB, wrA, wrB, wA, wB, k2A, k2B, bnA, bnB; };

__device__ __forceinline__ void scan_load_raw(ScanRaw& R, const half_t* __restrict__ Z, const half_t* __restrict__ LO, size_t mb, int t, int hc8) {
    const half_t* zp = Z + (mb + t) * NIN + hc8; const half_t* lp = LO + (mb + t) * 1536 + hc8;
    R.zr = *(const h8*)(zp); R.zk = *(const h8*)(zp + 512); R.zv = *(const h8*)(zp + 1024); R.lw = *(const h8*)(lp); R.la = *(const h8*)(lp + 512);
    if (t > 0) { R.pr = *(const h8*)(zp - NIN); R.pk = *(const h8*)(zp - NIN + 512); R.pv = *(const h8*)(zp - NIN + 1024); }
    else { R.pr = (h8){0, 0, 0, 0, 0, 0, 0, 0}; R.pk = R.pr; R.pv = R.pr; }
}

#define SCAN_BAR() do { asm volatile("s_waitcnt lgkmcnt(0)" ::: "memory"); __builtin_amdgcn_s_barrier(); asm volatile("" ::: "memory"); } while (0)
__device__ void phase_scan(LAS unsigned char* lds, const Params& P) {
    unsigned char* ws = P.ws;
    const half_t* Z = (const half_t*)(ws + WS_Z); const half_t* LO = (const half_t*)(ws + WS_LO);
    unsigned long long* XS = (unsigned long long*)(ws + WS_XS); half_t* Y = (half_t*)(ws + WS_Y);
    const int tid = threadIdx.x, lane = tid & 63, wave = __builtin_amdgcn_readfirstlane(tid >> 6);
    LAS float* bufs = (LAS float*)(lds + SC_BUF); LAS float* scal = (LAS float*)(lds + SC_SCAL); LAS float* ybs = (LAS float*)(lds + SC_YB);
    LAS half_t* vring = (LAS half_t*)(lds + SC_VR); LAS float* bring = (LAS float*)(lds + SC_BR); LAS float* vtb = (LAS float*)(lds + SC_VT);
    for (int item = blockIdx.x; item < 256; item += gridDim.x) {
        const int half = item & 1, bh = item >> 1, h = bh & 7, b = bh >> 3;
        const size_t mb = (size_t)b * SEQ;
        LAS float* cst = (LAS float*)(lds + SC_CST);
        if (tid < 64) { const int hc = h * 64 + tid; cst[tid] = P.in[5][hc]; cst[64 + tid] = P.in[5][512 + hc]; cst[128 + tid] = P.in[5][1024 + hc]; cst[192 + tid] = P.in[6][hc];
            cst[256 + tid] = P.in[8][hc]; cst[320 + tid] = P.in[11][hc]; cst[384 + tid] = P.in[12][hc]; cst[448 + tid] = P.in[13][hc]; }
        __syncthreads();
        if (wave >= 4) {
            const int pw = wave - 4, s8 = lane >> 3, cg = lane & 7, hc8 = h * 64 + cg * 8, tt = pw * 8 + s8;
            const int ptid = tid - 256, ft = ptid >> 3, q = ptid & 7, oc = h * 64 + half * 32 + q * 4;
            const f32x4 lng = *(const f32x4*)(P.in[14] + oc), lnb = *(const f32x4*)(P.in[15] + oc);
            unsigned long long* xs_mine = XS + ((size_t)(bh * 2 + half)) * SEQ; const unsigned long long* xs_peer = XS + ((size_t)(bh * 2 + (half ^ 1))) * SEQ;
#define SCAN_Y4(fc) (f32x4){ybs[((fc) & 3) * (32 * 33) + (q * 4 + 0) * 33 + ft], ybs[((fc) & 3) * (32 * 33) + (q * 4 + 1) * 33 + ft], ybs[((fc) & 3) * (32 * 33) + (q * 4 + 2) * 33 + ft], ybs[((fc) & 3) * (32 * 33) + (q * 4 + 3) * 33 + ft]}
#define SCAN_PUBLISH(fc) do { f32x4 y4 = SCAN_Y4(fc); { const h4 vq_ = *(const LAS h4*)(vring + (((fc) & 3) * TC + ft) * 32 + q * 4); const float kr_ = bring[(((fc) & 3) * TC + ft) * 2 + 1]; \
                y4[0] += (float)vq_[0] * kr_; y4[1] += (float)vq_[1] * kr_; y4[2] += (float)vq_[2] * kr_; y4[3] += (float)vq_[3] * kr_; }     \
                float s1 = (y4[0] + y4[1]) + (y4[2] + y4[3]), s2 = (y4[0] * y4[0] + y4[1] * y4[1]) + (y4[2] * y4[2] + y4[3] * y4[3]); \
                s1 = red8(s1); s2 = red8(s2) + 1e-30f; \
                if (q == 0) __hip_atomic_store(xs_mine + (fc) * TC + ft, ((unsigned long long)__float_as_uint(s2) << 32) | __float_as_uint(s1), __ATOMIC_RELAXED, __HIP_MEMORY_SCOPE_AGENT); } while (0)
#define SCAN_FINAL_LOAD(fz, G4, PW) do { const int t_ = (fz) * TC + ft; G4 = *(const h4*)(LO + (mb + t_) * 1536 + 1024 + oc); PW = __hip_atomic_load(xs_peer + t_, __ATOMIC_RELAXED, __HIP_MEMORY_SCOPE_AGENT); } while (0)
#define SCAN_FINAL(fz, G4, PW) do { const int t_ = (fz) * TC + ft; f32x4 y4 = SCAN_Y4(fz); \
                const h4 v4 = *(const LAS h4*)(vring + (((fz) & 3) * TC + ft) * 32 + q * 4); const f32x2 bk_ = *(const LAS f32x2*)(bring + (((fz) & 3) * TC + ft) * 2); const float bon_ = bk_[0]; \
                y4[0] += (float)v4[0] * bk_[1]; y4[1] += (float)v4[1] * bk_[1]; y4[2] += (float)v4[2] * bk_[1]; y4[3] += (float)v4[3] * bk_[1]; \
                const h4 g4 = G4; unsigned long long pw_ = PW; \
                { unsigned sp_ = 0; while (pw_ == 0ull && ++sp_ < (1u << 22)) { __builtin_amdgcn_s_sleep(1); pw_ = __hip_atomic_load(xs_peer + t_, __ATOMIC_RELAXED, __HIP_MEMORY_SCOPE_AGENT); } } \
                float s1 = (y4[0] + y4[1]) + (y4[2] + y4[3]), s2 = (y4[0] * y4[0] + y4[1] * y4[1]) + (y4[2] * y4[2] + y4[3] * y4[3]); \
                s1 = red8(s1) + __uint_as_float((unsigned)pw_); s2 = red8(s2) + __uint_as_float((unsigned)(pw_ >> 32)); \
                const float mean = s1 * (1.0f / 64.0f), var = fmaxf(s2 * (1.0f / 64.0f) - mean * mean, 0.f), rstd = __builtin_amdgcn_rsqf(var + GN_EPS); \
                float o_[4]; \
                _Pragma("unroll") for (int j = 0; j < 4; ++j) o_[j] = ((y4[j] - mean) * rstd * lng[j] + lnb[j] + bon_ * (float)v4[j]) * (float)g4[j]; \
                u32x2 w2_; w2_.x = pk2h(o_[0], o_[1]); w2_.y = pk2h(o_[2], o_[3]); *(u32x2*)(Y + (mb + t_) * DM + oc) = w2_; } while (0)
            ScanRaw Ra, Rb;
            scan_load_raw(Ra, Z, LO, mb, tt, hc8);
#define SCAN_PROD_ITER(ch, CUR, NXT) do { \
                const int pc_ = (ch) + 1; \
                h4 fg4_ = (h4){0, 0, 0, 0}; unsigned long long fpw_ = 0ull; if ((ch) >= 2) SCAN_FINAL_LOAD((ch) - 2, fg4_, fpw_);     \
                  \
                float wv_[8]; half_t* wdst_ = nullptr; f32x4 pv_; const bool pdo_ = (pc_ < 64) && (ptid < 128); \
                if (pc_ < 64 && ptid < 84) { int it_ = item * 5376 + pc_ * 84 + ptid; const float* src_; half_t* db_; int N_, ldd_, kind_ = 0; \
                    if (it_ < 131072) { src_ = P.in[18]; db_ = (half_t*)(ws + WS_WOUT); N_ = DM; ldd_ = DM; } \
                    else if ((it_ -= 131072) < 360448) { src_ = P.in[21]; db_ = (half_t*)(ws + WS_WGU); N_ = DFF; ldd_ = DM; kind_ = 1; } \
                    else if ((it_ -= 360448) < 360448) { src_ = P.in[22]; db_ = (half_t*)(ws + WS_WGU); N_ = DFF; ldd_ = DM; kind_ = 2; } \
                    else if ((it_ -= 360448) < 360448) { src_ = P.in[23]; db_ = (half_t*)(ws + WS_WDN); N_ = DM; ldd_ = DFF; } \
                    else if ((it_ -= 360448) < 131072) { src_ = P.in[25]; db_ = (half_t*)(ws + WS_WPLG); N_ = DM; ldd_ = DM; } \
                    else { it_ -= 131072; src_ = P.in[24]; db_ = (half_t*)(ws + WS_WPLP); N_ = DM; ldd_ = DPLE; } \
                    const int kg_ = it_ / N_, n_ = it_ - kg_ * N_; \
                    const int row_ = kind_ ? ((n_ >> 7) * 256 + (n_ & 127) + (kind_ == 2 ? 128 : 0)) : n_; \
                    const float* sp_ = src_ + (size_t)(kg_ * 8) * N_ + n_; \
                    _Pragma("unroll") for (int e = 0; e < 8; ++e) wv_[e] = sp_[(size_t)e * N_]; \
                    wdst_ = db_ + (size_t)row_ * ldd_ + kg_ * 8; } \
                if (pdo_) pv_ = ((const f32x4*)P.in[1])[item * 8192 + pc_ * 128 + ptid]; \
                if (pc_ + 1 < 64) scan_load_raw(NXT, Z, LO, mb, (pc_ + 1) * TC + tt, hc8); \
                if (pc_ < 64) { \
                    LAS float* dst = bufs + (pc_ & 1) * (TC * STEPF) + tt * STEPF + cg * 8; LAS float* dsc = scal + (pc_ & 1) * (TC * 4); \
                    float kk[8], wr_[8], w_[8], k2[8], bn[8], vv_[8]; float ss = 0.f, brs = 0.f, krs = 0.f, bons = 0.f; \
                    float mu_r[8], mu_k[8], mu_v[8], w0c[8], a0c[8], kkc[8], kac[8], rkc[8]; \
                    _Pragma("unroll") for (int hf = 0; hf < 2; ++hf) { const LAS float* cp = cst + cg * 8 + hf * 4; \
                        const f32x4 c0 = *(const LAS f32x4*)(cp), c1 = *(const LAS f32x4*)(cp + 64), c2 = *(const LAS f32x4*)(cp + 128), c3 = *(const LAS f32x4*)(cp + 192), \
                                    c4 = *(const LAS f32x4*)(cp + 256), c5 = *(const LAS f32x4*)(cp + 320), c6 = *(const LAS f32x4*)(cp + 384), c7 = *(const LAS f32x4*)(cp + 448); \
                        _Pragma("unroll") for (int j = 0; j < 4; ++j) { mu_r[hf * 4 + j] = c0[j]; mu_k[hf * 4 + j] = c1[j]; mu_v[hf * 4 + j] = c2[j]; w0c[hf * 4 + j] = c3[j]; a0c[hf * 4 + j] = c4[j]; kkc[hf * 4 + j] = c5[j]; kac[hf * 4 + j] = c6[j]; rkc[hf * 4 + j] = c7[j]; } } \
                    _Pragma("unroll") for (int e = 0; e < 8; ++e) { \
                        const float r0 = (float)CUR.zr[e], k0 = (float)CUR.zk[e], v0 = (float)CUR.zv[e]; \
                        const float r = r0 + ((float)CUR.pr[e] - r0) * mu_r[e], k = k0 + ((float)CUR.pk[e] - k0) * mu_k[e]; vv_[e] = v0 + ((float)CUR.pv[e] - v0) * mu_v[e]; \
                        const float sg = sigm(w0c[e] + (float)CUR.lw[e]); \
                        const float w = __builtin_amdgcn_exp2f(-0.875057039f * sg); \
                        const float a = sigm(a0c[e] + (float)CUR.la[e]); \
                        const float kq = k * kkc[e]; ss += kq * kq; kk[e] = kq; \
                        k2[e] = k * (1.0f + (a - 1.0f) * kac[e]); \
                        bn[e] = -kq * a; brs += bn[e] * r; \
                        const float pr = k2[e] * r; krs += pr; bons += pr * rkc[e]; \
                        w_[e] = w; wr_[e] = w * r; } \
                    ss = red8(ss); brs = red8(brs); krs = red8(krs); bons = red8(bons); \
                    const float rn = __builtin_amdgcn_rsqf(fmaxf(ss, 1e-24f)); brs *= rn; \
                    _Pragma("unroll") for (int e = 0; e < 8; ++e) { kk[e] *= rn; bn[e] *= rn; wr_[e] += brs * kk[e]; }     \
                    *(LAS f32x4*)(dst) = (f32x4){kk[0], kk[1], kk[2], kk[3]}; *(LAS f32x4*)(dst + 4) = (f32x4){kk[4], kk[5], kk[6], kk[7]}; \
                    *(LAS f32x4*)(dst + 64) = (f32x4){wr_[0], wr_[1], wr_[2], wr_[3]}; *(LAS f32x4*)(dst + 68) = (f32x4){wr_[4], wr_[5], wr_[6], wr_[7]}; \
                    *(LAS f32x4*)(dst + 128) = (f32x4){w_[0], w_[1], w_[2], w_[3]}; *(LAS f32x4*)(dst + 132) = (f32x4){w_[4], w_[5], w_[6], w_[7]}; \
                    *(LAS f32x4*)(dst + 192) = (f32x4){k2[0], k2[1], k2[2], k2[3]}; *(LAS f32x4*)(dst + 196) = (f32x4){k2[4], k2[5], k2[6], k2[7]}; \
                    *(LAS f32x4*)(dst + 256) = (f32x4){bn[0], bn[1], bn[2], bn[3]}; *(LAS f32x4*)(dst + 260) = (f32x4){bn[4], bn[5], bn[6], bn[7]}; \
                    if ((cg >> 2) == half) { LAS float* vt_ = vtb + (pc_ & 1) * (32 * TC) + ((cg & 3) * 8) * TC + tt; _Pragma("unroll") for (int e = 0; e < 8; ++e) vt_[e * TC] = vv_[e]; } \
                    if (cg == 0) *(LAS f32x2*)(bring + ((pc_ & 3) * TC + tt) * 2) = (f32x2){bons, krs}; \
                    if ((cg >> 2) == half) { u32x4 vw_; vw_.x = pk2h(vv_[0], vv_[1]); vw_.y = pk2h(vv_[2], vv_[3]); vw_.z = pk2h(vv_[4], vv_[5]); vw_.w = pk2h(vv_[6], vv_[7]); \
                        *(LAS u32x4*)(vring + ((pc_ & 3) * TC + tt) * 32 + (cg & 3) * 8) = vw_; } \
                } \
                if ((ch) >= 1) SCAN_PUBLISH((ch) - 1); \
                if ((ch) >= 2) SCAN_FINAL((ch) - 2, fg4_, fpw_); \
                if (wdst_) { u32x4 ww_; ww_.x = pk2h(wv_[0], wv_[1]); ww_.y = pk2h(wv_[2], wv_[3]); ww_.z = pk2h(wv_[4], wv_[5]); ww_.w = pk2h(wv_[6], wv_[7]); *(u32x4*)wdst_ = ww_; } \
                if (pdo_) { u32x2 pw2_; pw2_.x = pk2h(pv_[0], pv_[1]); pw2_.y = pk2h(pv_[2], pv_[3]); ((u32x2*)(ws + WS_P16))[item * 8192 + pc_ * 128 + ptid] = pw2_; } \
                __syncthreads(); \
            } while (0)
            for (int ch = -1; ch < 63; ch += 2) { SCAN_PROD_ITER(ch, Ra, Rb); SCAN_PROD_ITER(ch + 1, Rb, Ra); }
            SCAN_PROD_ITER(63, Ra, Rb);
#undef SCAN_PROD_ITER
            { h4 ga_, gb_; unsigned long long pa_, pb_; SCAN_FINAL_LOAD(62, ga_, pa_); SCAN_FINAL_LOAD(63, gb_, pb_); SCAN_PUBLISH(63); SCAN_FINAL(62, ga_, pa_); SCAN_FINAL(63, gb_, pb_); }
#undef SCAN_Y4
#undef SCAN_PUBLISH
#undef SCAN_FINAL
#undef SCAN_FINAL_LOAD
            __syncthreads();
        } else {
            const int row = wave * 8 + (lane >> 3), kl = lane & 7;
            f32x2 S0 = {0.f, 0.f}, S1 = {0.f, 0.f}, S2 = {0.f, 0.f}, S3 = {0.f, 0.f};
            __syncthreads();
            for (int ch = 0; ch < 64; ++ch) {
                const LAS float* src = bufs + (ch & 1) * (TC * STEPF); const LAS float* ssc = scal + (ch & 1) * (TC * 4); LAS float* yb = ybs + (ch & 3) * (32 * 33) + row * 33 + kl; float ykeep = 0.f;
                const LAS float* sbk = src + kl * 8; const LAS float* vtr = vtb + (ch & 1) * (32 * TC) + row * TC; f32x4 vvg[2]; vvg[0] = *(const LAS f32x4*)(vtr);
#define SCAN_LOAD(Q, tt) do { const LAS float* sb = sbk + (tt) * STEPF; \
                    Q.kkA = *(const LAS f32x4*)(sb); Q.kkB = *(const LAS f32x4*)(sb + 4); Q.wrA = *(const LAS f32x4*)(sb + 64); Q.wrB = *(const LAS f32x4*)(sb + 68); \
                    Q.wA = *(const LAS f32x4*)(sb + 128); Q.wB = *(const LAS f32x4*)(sb + 132); Q.k2A = *(const LAS f32x4*)(sb + 192); Q.k2B = *(const LAS f32x4*)(sb + 196); \
                    Q.bnA = *(const LAS f32x4*)(sb + 256); Q.bnB = *(const LAS f32x4*)(sb + 260); } while (0)
#define SCAN_VPREF(st) do { if ((((st) & 3) == 0) && ((st) + 4 < TC)) vvg[(((st) >> 2) + 1) & 1] = *(const LAS f32x4*)(vtr + (st) + 4); } while (0)
#define SCAN_COMPUTE(Q, tt) do { const float vvs_ = vvg[((tt) >> 2) & 1][(tt) & 3]; \
                    f32x2 pa2 = S0 * (f32x2){Q.kkA[0], Q.kkA[1]}; pa2 = S1 * (f32x2){Q.kkA[2], Q.kkA[3]} + pa2; pa2 = S2 * (f32x2){Q.kkB[0], Q.kkB[1]} + pa2; pa2 = S3 * (f32x2){Q.kkB[2], Q.kkB[3]} + pa2; \
                    f32x2 py2 = S0 * (f32x2){Q.wrA[0], Q.wrA[1]}; py2 = S1 * (f32x2){Q.wrA[2], Q.wrA[3]} + py2; py2 = S2 * (f32x2){Q.wrB[0], Q.wrB[1]} + py2; py2 = S3 * (f32x2){Q.wrB[2], Q.wrB[3]} + py2; \
                    float pa = pa2[0] + pa2[1], py = py2[0] + py2[1]; \
                    pa = red8(pa); py = red8(py); \
                    const f32x2 vv2 = {vvs_, vvs_}, pav = {pa, pa}; \
                    S0 = S0 * (f32x2){Q.wA[0], Q.wA[1]} + vv2 * (f32x2){Q.k2A[0], Q.k2A[1]}; S0 = pav * (f32x2){Q.bnA[0], Q.bnA[1]} + S0; \
                    S1 = S1 * (f32x2){Q.wA[2], Q.wA[3]} + vv2 * (f32x2){Q.k2A[2], Q.k2A[3]}; S1 = pav * (f32x2){Q.bnA[2], Q.bnA[3]} + S1; \
                    S2 = S2 * (f32x2){Q.wB[0], Q.wB[1]} + vv2 * (f32x2){Q.k2B[0], Q.k2B[1]}; S2 = pav * (f32x2){Q.bnB[0], Q.bnB[1]} + S2; \
                    S3 = S3 * (f32x2){Q.wB[2], Q.wB[3]} + vv2 * (f32x2){Q.k2B[2], Q.k2B[3]}; S3 = pav * (f32x2){Q.bnB[2], Q.bnB[3]} + S3; \
                    { const float y_ = py;                                     ykeep = (kl == ((tt) & 7)) ? y_ : ykeep;     \
                      if (((tt) & 7) == 7) yb[(tt) - 7] = ykeep; } \
                } while (0)
                ScanStep q0, q1, q2;
                SCAN_LOAD(q0, 0); SCAN_LOAD(q1, 1);
#pragma unroll
                for (int tt = 0; tt < TC; tt += 3) {
                    if (tt + 2 < TC) SCAN_LOAD(q2, tt + 2);
                    __builtin_amdgcn_sched_barrier(0);
                    SCAN_VPREF(tt); SCAN_COMPUTE(q0, tt);
                    if (tt + 1 < TC) { if (tt + 3 < TC) SCAN_LOAD(q0, tt + 3); __builtin_amdgcn_sched_barrier(0); SCAN_VPREF(tt + 1); SCAN_COMPUTE(q1, tt + 1); }
                    if (tt + 2 < TC) { if (tt + 4 < TC) SCAN_LOAD(q1, tt + 4); __builtin_amdgcn_sched_barrier(0); SCAN_VPREF(tt + 2); SCAN_COMPUTE(q2, tt + 2); }
                }
#undef SCAN_LOAD
#undef SCAN_VPREF
#undef SCAN_COMPUTE
                __syncthreads();
            }
            __syncthreads();
        }
    }
}

__device__ void phase_ln1(const Params& P) {
    half_t* H1 = (half_t*)(P.ws + WS_H1);
    const int lane = threadIdx.x & 63, wv = threadIdx.x >> 6;
    for (int row = blockIdx.x * 8 + wv; row < MTOK; row += gridDim.x * 8) ln_row_to_f16(P.out + (size_t)row * DM, P.in[19], P.in[20], H1 + (size_t)row * DM, lane);
}
__device__ void phase_ln2(const Params& P) {
    const int lane = threadIdx.x & 63, wv = threadIdx.x >> 6;
    const float* g = P.in[26]; const float* b = P.in[27];
    for (int row = blockIdx.x * 8 + wv; row < MTOK; row += gridDim.x * 8) {
        float* xrow = P.out + (size_t)row * DM;
        f32x4 v[4]; float s = 0.f;
#pragma unroll
        for (int j = 0; j < 4; ++j) { v[j] = *(const f32x4*)(xrow + j * 256 + lane * 4); s += (v[j][0] + v[j][1]) + (v[j][2] + v[j][3]); }
        const float mu = wave_sum(s) * (1.0f / 1024.0f); float q = 0.f;
#pragma unroll
        for (int j = 0; j < 4; ++j) { v[j] = v[j] - mu; q += (v[j][0] * v[j][0] + v[j][1] * v[j][1]) + (v[j][2] * v[j][2] + v[j][3] * v[j][3]); }
        const float rstd = __builtin_amdgcn_rsqf(wave_sum(q) * (1.0f / 1024.0f) + LN_EPS);
#pragma unroll
        for (int j = 0; j < 4; ++j) { const f32x4 gg = *(const f32x4*)(g + j * 256 + lane * 4), bb = *(const f32x4*)(b + j * 256 + lane * 4);
            *(f32x4*)(xrow + j * 256 + lane * 4) = v[j] * rstd * gg + bb; }
    }
}

__global__ void __launch_bounds__(NTHREADS) fwd_megakernel(Params P) {
    extern __shared__ __attribute__((aligned(16))) unsigned char lds_raw[];
    LAS unsigned char* lds = (LAS unsigned char*)lds_raw;
    cg::grid_group grid = cg::this_grid();
    if (P.ph_hi < 0) grid.sync();
    volatile LAS unsigned* xst = (volatile LAS unsigned*)(lds + LDS_BYTES);
    if (threadIdx.x < 2) xst[threadIdx.x] = 0u;
    __syncthreads();
    XcdBarrier xbar = xcd_barrier_post((unsigned*)P.ws, xst);
    unsigned char* ws = P.ws;
    const int lo = P.ph_lo, hi = P.ph_hi, G = gridDim.x, bx = blockIdx.x;
#define IN(k) (lo <= (k) && (k) < hi)
#define REP(k) for (int rep_ = 0; rep_ < (((PROBE_DUP >> (k)) & 1) ? 2 : 1); ++rep_)
#ifndef PROBE_SYNCS
#define PROBE_SYNCS 0
#endif
#define SEAM(k) do { if (IN(k) && IN((k) + 1)) { xcd_barrier(xbar); for (int s_ = 0; s_ < PROBE_SYNCS; ++s_) xcd_barrier(xbar); } } while (0)
    if (IN(0)) REP(0) { phase_prologue(lds, P); } SEAM(0);
    if (IN(1)) REP(1) {
        pg8::Gemm g{(const half_t*)(ws + WS_H0), (const half_t*)(ws + WS_WIN), MTOK, NIN, DM}; pg8::StaticOrder S; S.init(MTOK, NIN, G, bx);
        pg8::EpiH E{(half_t*)(ws + WS_Z), NIN, 0, nullptr};
        pg8::gemm_phase<pg8::EpiH>(lds, g, S, E);
    } SEAM(1);
    if (IN(2)) REP(2) { phase_prep(P); } SEAM(2);
    if (IN(3)) REP(3) {
        { pg8::Gemm g{(const half_t*)(ws + WS_AL), (const half_t*)(ws + WS_WLORA), MTOK, 1536, 256}; pg8::StaticOrder S; S.init(MTOK, 1536, G, bx);
            pg8::EpiH E{(half_t*)(ws + WS_LO), 1536, 0, nullptr};
            pg8::gemm_phase<pg8::EpiH>(lds, g, S, E); }
    } SEAM(3);
    if (IN(4)) REP(4) { phase_scan(lds, P); } SEAM(4);
    LAS unsigned char* tl = lds + LDS_TAB;
    if (IN(6)) REP(6) {
        pg8::Gemm g{(const half_t*)(ws + WS_Y), (const half_t*)(ws + WS_WOUT), MTOK, DM, DM}; pg8::StaticOrder S; S.init(MTOK, DM, G, bx);
        pg8::PanelStats st{(unsigned long long*)(ws + WS_XB1), (unsigned*)(ws + CTL_CNT1), LN_EPS};
        pg8::EpiLN<false> E{(const half_t*)(ws + WS_H0), nullptr, P.in[19], P.in[20], (half_t*)(ws + WS_H1), nullptr, st, tl};
        pg8::gemm_phase<pg8::EpiLN<false>>(lds, g, S, E);
    } SEAM(6);
    if (IN(7)) REP(7) {
        { pg8::Gemm g{(const half_t*)(ws + WS_H1), (const half_t*)(ws + WS_WGU), MTOK, 2 * DFF, DM}; pg8::StaticOrder S; S.init(MTOK, 2 * DFF, G, bx);
            pg8::EpiSwiGLU E{(half_t*)(ws + WS_ACT), DFF};
            pg8::gemm_phase<pg8::EpiSwiGLU>(lds, g, S, E); }
        { pg8::Gemm g{(const half_t*)(ws + WS_P16), (const half_t*)(ws + WS_WPLP), MTOK, DM, DPLE}; pg8::StaticOrder S; S.init(MTOK, DM, G, bx);
            pg8::EpiH E{(half_t*)(ws + WS_E2), DM, 0, nullptr};
            pg8::gemm_phase<pg8::EpiH>(lds, g, S, E); }
        { pg8::Gemm g{(const half_t*)(ws + WS_H1), (const half_t*)(ws + WS_WPLG), MTOK, DM, DM}; pg8::StaticOrder S; S.init(MTOK, DM, G, bx);
            pg8::EpiE E{(half_t*)(ws + WS_E2), DM};
            pg8::gemm_phase<pg8::EpiE>(lds, g, S, E); }
    } SEAM(7);
    if (IN(8)) {
        pg8::Gemm g{(const half_t*)(ws + WS_ACT), (const half_t*)(ws + WS_WDN), MTOK, DM, DFF}; pg8::StaticOrder S; S.init(MTOK, DM, G, bx);
        pg8::PanelStats st{(unsigned long long*)(ws + WS_XB2), (unsigned*)(ws + CTL_CNT2), LN_EPS};
        pg8::EpiLN<true> E{(const half_t*)(ws + WS_H1), (const half_t*)(ws + WS_E2), P.in[26], P.in[27], nullptr, P.out, st, tl};
        pg8::gemm_phase<pg8::EpiLN<true>>(lds, g, S, E);
    }
#undef IN
#undef SEAM
}

extern "C" void kernel_launch(void* const* d_in, const int* in_sizes, int n_in, void* d_out, int out_size, void* d_ws, size_t ws_size, hipStream_t stream) {
    static int grid_blocks = 0;
    if (grid_blocks == 0) {
        if (n_in != 28 || out_size != MTOK * DM || ws_size < WS_END) { fprintf(stderr, "kernel_launch: unexpected shapes (n_in %d, out %d, ws %zu, need %zu)\n", n_in, out_size, ws_size, (size_t)WS_END); grid_blocks = -1; return; }
        int dev = 0, cus = 0, per_cu = 0;
        (void)hipGetDevice(&dev);
        (void)hipDeviceGetAttribute(&cus, hipDeviceAttributeMultiprocessorCount, dev);
        if (hipFuncSetAttribute((const void*)fwd_megakernel, hipFuncAttributeMaxDynamicSharedMemorySize, LDS_TOTAL) != hipSuccess) { fprintf(stderr, "kernel_launch: hipFuncSetAttribute failed\n"); grid_blocks = -1; return; }
        if (hipOccupancyMaxActiveBlocksPerMultiprocessor(&per_cu, (const void*)fwd_megakernel, NTHREADS, LDS_TOTAL) != hipSuccess || per_cu < 1) { fprintf(stderr, "kernel_launch: occupancy query failed (%d)\n", per_cu); per_cu = 1; (void)hipGetLastError(); }
        grid_blocks = cus * per_cu;
    }
    if (grid_blocks < 0) return;
    Params p{};
    for (int i = 0; i < 28; ++i) p.in[i] = (const float*)d_in[i];
    p.out = (float*)d_out; p.ws = (unsigned char*)d_ws;
    static_assert(WS_XS == CTL_BYTES && WS_XS + XS_BYTES <= WS_WIN, "control words and exchange slots are one contiguous region");
    (void)hipMemsetAsync(d_ws, 0, CTL_BYTES + XS_BYTES, stream);
#if N_LAUNCH_MODE == 1
    p.ph_lo = 0; p.ph_hi = NPHASE;
    { void* args[] = {&p};
        hipError_t e = hipLaunchCooperativeKernel((const void*)fwd_megakernel, dim3(grid_blocks), dim3(NTHREADS), args, LDS_TOTAL, stream);
        if (e != hipSuccess) fprintf(stderr, "cooperative launch failed: %s (grid %d)\n", hipGetErrorString(e), grid_blocks); }
#else
    for (int ph = 0; ph < NPHASE; ++ph) {
        p.ph_lo = ph; p.ph_hi = ph + 1;
        void* args[] = {&p};
        hipError_t e = hipLaunchCooperativeKernel((const void*)fwd_megakernel, dim3(grid_blocks), dim3(NTHREADS), args, LDS_TOTAL, stream);
        if (e != hipSuccess) { fprintf(stderr, "launch %d failed: %s (grid %d)\n", ph, hipGetErrorString(e), grid_blocks); break; }
    }
#endif
}
```
